# Optimizing an MI355X kernel written in HIP

```python
import jax, jax.numpy as jnp
from jax import lax
import numpy as np

D_MODEL = 1024
BATCH = 16
SEQ = 4096
DEPTH = 2
DEC_BATCH = 8
DEC_SEQ = 64
PAST_LEN = 2048

CHUNK = 64
N_BRANCH = 4
W_BR = D_MODEL // 2
GMLP_CHUNK = 128
GMLP_HEADS = 4
GMLP_HD = W_BR // GMLP_HEADS
CONV_K = 31
POOL_WINDOWS = (2, 4, 8, 16)
POOL_GROUPS = len(POOL_WINDOWS)
POOL_GD = W_BR // POOL_GROUPS
POOL_STATE = max(POOL_WINDOWS) - 1
SHORT_K = 3
N_PARTS = 12
N_IN = N_PARTS * W_BR + N_BRANCH * D_MODEL
SPLITS = tuple(W_BR * i for i in range(1, N_PARTS + 1))
EPS = 1e-6

kernel_name = 'hybrid_gated_branch_streaming_step'


def rmsnorm(x, g):
    xf = x.astype(jnp.float32)
    r = lax.rsqrt(jnp.mean(xf * xf, axis=-1, keepdims=True) + EPS)
    return (xf * r).astype(x.dtype) * g


def layernorm(x, g, b):
    xf = x.astype(jnp.float32)
    mu = jnp.mean(xf, axis=-1, keepdims=True)
    var = jnp.mean(jnp.square(xf - mu), axis=-1, keepdims=True)
    return ((xf - mu) * lax.rsqrt(var + EPS)).astype(x.dtype) * g + b


def causal_depthwise(ext, w):
    c = ext.shape[-1]
    return lax.conv_general_dilated(ext, w[:, None, :].astype(ext.dtype), window_strides=(1,),
                                    padding='VALID', dimension_numbers=('NWC', 'WIO', 'NWC'),
                                    feature_group_count=c)


def gmlp_spatial(u, v, w_s, b_s):
    bsz, t, _ = v.shape
    ln = min(t, GMLP_CHUNK)
    n = t // ln
    mask = jnp.tril(jnp.ones((ln, ln), v.dtype))
    w = w_s[:, :ln, :ln] * mask
    vc = v.reshape(bsz, n, ln, GMLP_HEADS, GMLP_HD)
    mixed = jnp.einsum('hts,bnshc->bnthc', w, vc) + b_s[:, :ln].T[None, None, :, :, None]
    return u * mixed.reshape(bsz, t, W_BR)


def multiscale_pool(ext, start_pos, pool_w, pool_scale):
    bsz = ext.shape[0]
    t = ext.shape[1] - POOL_STATE
    xf = ext.astype(jnp.float32)
    cs = jnp.concatenate([jnp.zeros_like(xf[:, :1]), jnp.cumsum(xf, axis=1)], axis=1)
    pos = start_pos + jnp.arange(t)
    x_tok = xf[:, POOL_STATE:]
    outs = []
    for g, w in enumerate(POOL_WINDOWS):
        sl = slice(g * POOL_GD, (g + 1) * POOL_GD)
        hi = cs[:, POOL_STATE + 1:, sl]
        lo = cs[:, POOL_STATE + 1 - w:POOL_STATE + 1 - w + t, sl]
        cnt = jnp.minimum(pos + 1, w).astype(jnp.float32)[None, :, None]
        outs.append((hi - lo) / cnt - x_tok[:, :, sl])
    p = jnp.stack(outs, axis=2).astype(ext.dtype)
    p = jnp.einsum('btgc,gcd->btgd', p, pool_w).reshape(bsz, t, W_BR)
    return p * pool_scale


def trunk(x, conv_states, pool_states, short_states, start_pos, g_pre, g_post, w_in, b_gate,
          ln_v_g, ln_v_b, w_s, b_s, conv_b_w, conv_b_bias, ln_b_g, ln_b_b, pool_w, pool_scale,
          conv_d_w, w_branch, w_out):
    bsz, t, _ = x.shape
    new_conv, new_pool, new_short, v_rows = [], [], [], []
    for l in range(DEPTH):
        h = rmsnorm(x, g_pre[l])
        proj = h @ w_in[l]
        (a_u, a_v, a_z, b_a, b_b, b_z, c_x, c_z, d_b, d_c, d_x, d_z,
         gate_logits) = jnp.split(proj, SPLITS, axis=-1)
        v_n = layernorm(a_v, ln_v_g[l], ln_v_b[l])
        out_a = gmlp_spatial(a_u, v_n, w_s[l], b_s[l]) * jax.nn.silu(a_z)
        glu = b_a * jax.nn.sigmoid(b_b)
        ext_b = jnp.concatenate([conv_states[l], glu], axis=1)
        cb = causal_depthwise(ext_b, conv_b_w[l]) + conv_b_bias[l]
        out_b = jax.nn.silu(layernorm(cb, ln_b_g[l], ln_b_b[l])) * jax.nn.silu(b_z)
        ext_c = jnp.concatenate([pool_states[l], c_x], axis=1)
        out_c = multiscale_pool(ext_c, start_pos, pool_w[l], pool_scale[l]) * jax.nn.silu(c_z)
        ext_d = jnp.concatenate([short_states[l], d_c * d_x], axis=1)
        out_d = d_b * causal_depthwise(ext_d, conv_d_w[l]) * jax.nn.silu(d_z)
        gates = jax.nn.sigmoid(gate_logits + b_gate[l]).reshape(bsz, t, N_BRANCH, D_MODEL)
        merged = gates[:, :, 0] * (out_a @ w_branch[l, 0])
        merged = merged + gates[:, :, 1] * (out_b @ w_branch[l, 1])
        merged = merged + gates[:, :, 2] * (out_c @ w_branch[l, 2])
        merged = merged + gates[:, :, 3] * (out_d @ w_branch[l, 3])
        y = merged @ w_out[l]
        x = x + rmsnorm(y, g_post[l])
        new_conv.append(ext_b[:, -(CONV_K - 1):])
        new_pool.append(ext_c[:, -POOL_STATE:])
        new_short.append(ext_d[:, -(SHORT_K - 1):])
        v_rows.append(v_n)
    return x, jnp.stack(new_conv), jnp.stack(new_pool), jnp.stack(new_short), jnp.stack(v_rows)


def setup_inputs(seed: int = 0) -> dict:
    key = jax.random.key(seed)
    ks = jax.random.split(key, 22)
    n = jax.random.normal
    f32 = jnp.float32
    return {
        'x_prompt': n(ks[0], (BATCH, SEQ, D_MODEL), f32),
        'x_sample': n(ks[1], (DEC_BATCH, DEC_SEQ, D_MODEL), f32),
        'state_conformer_conv': 0.5 * n(ks[2], (DEPTH, DEC_BATCH, CONV_K - 1, W_BR), f32),
        'state_pool': n(ks[3], (DEPTH, DEC_BATCH, POOL_STATE, W_BR), f32),
        'state_short_conv': 0.5 * n(ks[4], (DEPTH, DEC_BATCH, SHORT_K - 1, W_BR), f32),
        'g_pre': 1.0 + 0.05 * n(ks[5], (DEPTH, D_MODEL), f32),
        'g_post': 1.0 + 0.05 * n(ks[6], (DEPTH, D_MODEL), f32),
        'w_in': n(ks[7], (DEPTH, D_MODEL, N_IN), f32) * D_MODEL ** -0.5,
        'b_gate': 0.02 * n(ks[8], (DEPTH, N_BRANCH * D_MODEL), f32),
        'ln_v_g': 1.0 + 0.05 * n(ks[9], (DEPTH, W_BR), f32),
        'ln_v_b': 0.02 * n(ks[10], (DEPTH, W_BR), f32),
        'w_s': n(ks[11], (DEPTH, GMLP_HEADS, GMLP_CHUNK, GMLP_CHUNK), f32) * GMLP_CHUNK ** -0.5,
        'b_s': 1.0 + 0.1 * n(ks[12], (DEPTH, GMLP_HEADS, GMLP_CHUNK), f32),
        'conv_b_w': n(ks[13], (DEPTH, CONV_K, W_BR), f32) * CONV_K ** -0.5,
        'conv_b_bias': 0.02 * n(ks[14], (DEPTH, W_BR), f32),
        'ln_b_g': 1.0 + 0.05 * n(ks[15], (DEPTH, W_BR), f32),
        'ln_b_b': 0.02 * n(ks[16], (DEPTH, W_BR), f32),
        'pool_w': n(ks[17], (DEPTH, POOL_GROUPS, POOL_GD, POOL_GD), f32) * POOL_GD ** -0.5,
        'pool_scale': 1.0 + 0.1 * n(ks[18], (DEPTH, W_BR), f32),
        'conv_d_w': n(ks[19], (DEPTH, SHORT_K, W_BR), f32) * SHORT_K ** -0.5,
        'w_branch': n(ks[20], (DEPTH, N_BRANCH, W_BR, D_MODEL), f32) * W_BR ** -0.5,
        'w_out': n(ks[21], (DEPTH, D_MODEL, D_MODEL), f32) * D_MODEL ** -0.5,
    }


def reference(x_prompt, x_sample, state_conformer_conv, state_pool, state_short_conv, g_pre, g_post,
              w_in, b_gate, ln_v_g, ln_v_b, w_s, b_s, conv_b_w, conv_b_bias, ln_b_g, ln_b_b,
              pool_w, pool_scale, conv_d_w, w_branch, w_out):
    assert x_sample.shape[1] <= CHUNK
    weights = (g_pre, g_post, w_in, b_gate, ln_v_g, ln_v_b, w_s, b_s, conv_b_w, conv_b_bias,
               ln_b_g, ln_b_b, pool_w, pool_scale, conv_d_w, w_branch, w_out)
    bp = x_prompt.shape[0]
    dt = x_prompt.dtype
    zc = jnp.zeros((DEPTH, bp, CONV_K - 1, W_BR), dt)
    zp = jnp.zeros((DEPTH, bp, POOL_STATE, W_BR), dt)
    zs = jnp.zeros((DEPTH, bp, SHORT_K - 1, W_BR), dt)
    y_prompt, conv_p, pool_p, short_p, _ = trunk(x_prompt, zc, zp, zs, 0, *weights)
    y_sample, conv_s, pool_s, short_s, v_s = trunk(x_sample, state_conformer_conv, state_pool,
                                                   state_short_conv, PAST_LEN, *weights)
    return (y_prompt, y_sample, conv_p, pool_p, short_p, conv_s, pool_s, short_s, v_s)
```

```cpp
#include <hip/hip_runtime.h>
#include <hip/hip_cooperative_groups.h>
#include <cstdio>
#include <cstdint>
namespace cg = cooperative_groups;
#define CHB 4
namespace pg8 {
#define PG8_LAS __attribute__((address_space(3)))
typedef unsigned short bf16_t;
typedef short bf16x8 __attribute__((ext_vector_type(8)));
typedef float f32x4 __attribute__((ext_vector_type(4)));
typedef unsigned u32x4 __attribute__((ext_vector_type(4)));
constexpr int BM = 256, BK = 64, HALF = 128, HTB = HALF * BK * 2  , STAGE_BYTES = 8 * HTB, NXCD = 8, WGM = 8;

__host__ __device__ __forceinline__ int lds_byte(int r, int c) { const int st = (r >> 4) * 2 + (c >> 5), rr = r & 15, cc = c & 31, ob = rr * 64 + cc * 2; return st * 1024 + (ob ^ (((ob >> 9) & 1) << 5)); }
__host__ __device__ __forceinline__ void stage_rc(int b, int& R, int& C) { const int st = b / 1024, sb = b % 1024, swz = sb ^ (((sb >> 9) & 1) << 5); R = (st >> 1) * 16 + swz / 64; C = (st & 1) * 32 + (swz % 64) / 2; }
__host__ __device__ __forceinline__ int perm32(int rho) { const int n = rho >> 4, i = rho & 15; return 8 * (i >> 2) + 4 * n + (i & 3); }

struct Unit { int pm, pn; };
struct Gemm { const bf16_t* A; const bf16_t* Bt; int M, N, K; };

struct StaticOrder {
    int nM, nN, nwg, G, c;
    __host__ __device__ void init(int M, int N, int G_, int c_) { nM = M / BM; nN = N / BM; nwg = nM * nN; G = G_; c = c_; }
    __host__ __device__ bool next(int i, Unit& u) const {
        const long L = (long)i * G + c; if (L >= nwg) return false;
        int wgid = (int)L; { const int q = nwg / NXCD, r = nwg % NXCD, xcd = wgid % NXCD, off = wgid / NXCD; wgid = (xcd < r ? xcd * (q + 1) : r * (q + 1) + (xcd - r) * q) + off; }
        const int nig = WGM * nN, gid = wgid / nig, fm = gid * WGM, gsz = (nM - fm) < WGM ? (nM - fm) : WGM;
        u.pm = fm + ((wgid % nig) % gsz); u.pn = (wgid % nig) / gsz; return true;
    }
    __device__ __forceinline__ void a_ready(const Unit&) const {}
    __device__ __forceinline__ void done(const Unit&) const {}
};
__device__ __forceinline__ unsigned cvt_pk_bf16(float lo, float hi) { unsigned r; asm volatile("v_cvt_pk_bf16_f32 %0, %1, %2" : "=v"(r) : "v"(lo), "v"(hi)); return r; }
typedef float f32x2 __attribute__((ext_vector_type(2)));
__device__ __forceinline__ float fast_sigmoid(float x) { return __builtin_amdgcn_rcpf(1.0f + __expf(-x)); }
__device__ __forceinline__ float fast_silu(float x) { return x * __builtin_amdgcn_rcpf(1.0f + __expf(-x)); }
__device__ __forceinline__ float bflo(unsigned w) { return __uint_as_float(w << 16); }
__device__ __forceinline__ float bfhi(unsigned w) { return __uint_as_float(w & 0xffff0000u); }

struct EpiProj {
    static constexpr bool PERM = true, AFTER_DRAIN = false, PROBE2 = true, CHAIN = false;
    bf16_t* O; const float* bgate; unsigned char* g8;
    __device__ __forceinline__ void operator()(const f32x4 (&acc)[2][2][4][2], const Unit& u, int wr, int wc, int fr, int fq) const {
        const int row0 = u.pm * BM + wr * 64 + fr; const int pn = u.pn, colt = pn * BM; const int col0 = colt + wc * 32 + 8 * fq;
        const int kind = (pn >= 24) ? 4 : (pn < 4 ? 5 : ((pn >= 6 && pn < 10) ? 1 : ((pn >= 16 && pn < 20) ? 2 : ((pn >= 20) ? 3 : 0))));
        const int oshift = (pn == 4 || pn == 5) ? -512 : ((pn >= 10 && pn < 16) ? -1024 : 0); const bool zs = (pn == 10 || pn == 11 || pn == 14 || pn == 15);
        if (kind == 0) {
#pragma unroll
            for (int ai = 0; ai < 2; ++ai)
#pragma unroll
                for (int m = 0; m < 4; ++m) { bf16_t* rowp = O + (size_t)(row0 + ai * HALF + m * 16) * 4096 + col0 + oshift;
#pragma unroll
                    for (int bj = 0; bj < 2; ++bj) { f32x4 v0 = acc[ai][bj][m][0], v1 = acc[ai][bj][m][1];
                        if (zs) {
#pragma unroll
                            for (int j = 0; j < 4; ++j) { v0[j] = fast_silu(v0[j]); v1[j] = fast_silu(v1[j]); } }
                        u32x4 w; w.x = cvt_pk_bf16(v0[0], v0[1]); w.y = cvt_pk_bf16(v0[2], v0[3]); w.z = cvt_pk_bf16(v1[0], v1[1]); w.w = cvt_pk_bf16(v1[2], v1[3]);
                        *(u32x4*)(rowp + bj * HALF) = w; } }
        } else if (kind == 4) {
            f32x4 bv[2][2];
#pragma unroll
            for (int bj = 0; bj < 2; ++bj)
#pragma unroll
                for (int n = 0; n < 2; ++n) bv[bj][n] = *(const f32x4*)(bgate + (col0 - 6144) + bj * HALF + 4 * n);
            unsigned char* img = g8 + (size_t)u.pm * 1048576 + (size_t)(pn - 24) * 65536 + (wr * 4 + wc) * 512 + (fr + 16 * fq) * 8;
#pragma unroll
            for (int ai = 0; ai < 2; ++ai)
#pragma unroll
                for (int m = 0; m < 4; ++m)
#pragma unroll
                    for (int bj = 0; bj < 2; ++bj) { const f32x4 v0 = acc[ai][bj][m][0] + bv[bj][0], v1 = acc[ai][bj][m][1] + bv[bj][1];
                        unsigned lo = 0u, hi = 0u;
#pragma unroll
                        for (int j = 0; j < 4; ++j) { lo = __builtin_amdgcn_cvt_pk_u8_f32(fmaxf(255.0f * fast_sigmoid(v0[j]), 1.0f), j, lo); hi = __builtin_amdgcn_cvt_pk_u8_f32(fmaxf(255.0f * fast_sigmoid(v1[j]), 1.0f), j, hi); }
                        typedef unsigned u32x2 __attribute__((ext_vector_type(2)));
                        *(u32x2*)(img + ((ai * 4 + m) * 2 + bj) * 4096) = (u32x2){lo, hi}; }
        } else {
            const int ocol = (kind == 5 ? pn * 128 : (kind == 1 ? 1024 + (pn - 6) * 128 : (kind == 2 ? 3072 + (pn - 16) * 128 : 3584 + (pn - 20) * 128))) + wc * 32 + 8 * fq;
#pragma unroll
            for (int ai = 0; ai < 2; ++ai)
#pragma unroll
                for (int m = 0; m < 4; ++m) { f32x4 r0, r1; const f32x4 a0 = acc[ai][0][m][0], a1 = acc[ai][0][m][1], b0 = acc[ai][1][m][0], b1 = acc[ai][1][m][1];
#pragma unroll
                    for (int j = 0; j < 4; ++j) {
                        if (kind == 1) { r0[j] = a0[j] * fast_sigmoid(b0[j]); r1[j] = a1[j] * fast_sigmoid(b1[j]); }
                        else if (kind == 2 || kind == 5) { r0[j] = a0[j] * fast_silu(b0[j]); r1[j] = a1[j] * fast_silu(b1[j]); }
                        else { r0[j] = a0[j] * b0[j]; r1[j] = a1[j] * b1[j]; } }
                    u32x4 w; w.x = cvt_pk_bf16(r0[0], r0[1]); w.y = cvt_pk_bf16(r0[2], r0[3]); w.z = cvt_pk_bf16(r1[0], r1[1]); w.w = cvt_pk_bf16(r1[2], r1[3]);
                    *(u32x4*)(O + (size_t)(row0 + ai * HALF + m * 16) * 4096 + ocol) = w; }
        }
    }
};
struct EpiPlain {
    static constexpr bool PERM = true, AFTER_DRAIN = false, PROBE2 = false, CHAIN = false;
    bf16_t* O; int ldc;
    __device__ __forceinline__ void operator()(const f32x4 (&acc)[2][2][4][2], const Unit& u, int wr, int wc, int fr, int fq) const {
        const int row0 = u.pm * BM + wr * 64 + fr; const int col0 = u.pn * BM + wc * 32 + 8 * fq;
#pragma unroll
        for (int ai = 0; ai < 2; ++ai)
#pragma unroll
            for (int m = 0; m < 4; ++m) { bf16_t* rowp = O + (size_t)(row0 + ai * HALF + m * 16) * ldc + col0;
#pragma unroll
                for (int bj = 0; bj < 2; ++bj) { const f32x4 v0 = acc[ai][bj][m][0], v1 = acc[ai][bj][m][1];
                    u32x4 w; w.x = cvt_pk_bf16(v0[0], v0[1]); w.y = cvt_pk_bf16(v0[2], v0[3]); w.z = cvt_pk_bf16(v1[0], v1[1]); w.w = cvt_pk_bf16(v1[2], v1[3]);
                    *(u32x4*)(rowp + bj * HALF) = w; } }
    }
};
#ifndef CHB
#define CHB 2
#endif
struct EpiBranch {
    static constexpr bool PERM = true, AFTER_DRAIN = false, PROBE2 = false, CHAIN = true;
    bf16_t* Mg; const bf16_t* proj; int rtm; const unsigned char* g8;
    __device__ __forceinline__ bool last(const Unit& u) const { return (u.pn >> 2) == 3; }
    typedef unsigned u32x2 __attribute__((ext_vector_type(2)));
    __device__ __forceinline__ void scale4(f32x4& v, const unsigned g, const unsigned h, bool div) const {
#pragma unroll
        for (int k = 0; k < 4; ++k) { const float gq = (float)((g >> (8 * k)) & 255u), hq = (float)((h >> (8 * k)) & 255u);
            v[k] *= gq * (div ? __builtin_amdgcn_rcpf(hq) : (1.0f / 255.0f)); }
    }
    __device__ __forceinline__ void chain(f32x4 (&acc)[2][2][4][2], const Unit& u, int wr, int wc, int fr, int fq) const {
        const int X = u.pn >> 2, pn = u.pn & 3, pm = u.pm - X * rtm;
        const int row0 = pm * BM + wr * 64 + fr; const int col0 = pn * BM + wc * 32 + 8 * fq;
        const bool div = X < 3; const int hoff = div ? 4 * 65536 : 0;
        const unsigned char* img = g8 + (size_t)pm * 1048576 + (size_t)(4 * X + pn) * 65536 + (wr * 4 + wc) * 512 + (fr + 16 * fq) * 8;
#pragma unroll
        for (int ai = 0; ai < 2; ++ai)
#pragma unroll
            for (int m = 0; m < 4; m += CHB) {
                u32x2 g[CHB][2], h[CHB][2];
#pragma unroll
                for (int q = 0; q < CHB; ++q) { const unsigned char* gp = img + ((ai * 4 + m + q) * 2) * 4096;
                    g[q][0] = *(const u32x2*)gp; g[q][1] = *(const u32x2*)(gp + 4096); h[q][0] = *(const u32x2*)(gp + hoff); h[q][1] = *(const u32x2*)(gp + hoff + 4096); }
                __builtin_amdgcn_sched_barrier(0);
#pragma unroll
                for (int q = 0; q < CHB; ++q) { scale4(acc[ai][0][m + q][0], g[q][0].x, h[q][0].x, div); scale4(acc[ai][0][m + q][1], g[q][0].y, h[q][0].y, div);
                    scale4(acc[ai][1][m + q][0], g[q][1].x, h[q][1].x, div); scale4(acc[ai][1][m + q][1], g[q][1].y, h[q][1].y, div); }
                __builtin_amdgcn_sched_barrier(0);
            }
        if (X == 3) {
#pragma unroll
            for (int ai = 0; ai < 2; ++ai)
#pragma unroll
                for (int m = 0; m < 4; ++m) { bf16_t* mp = Mg + (size_t)(row0 + ai * HALF + m * 16) * 1024 + col0;
#pragma unroll
                    for (int bj = 0; bj < 2; ++bj) { const f32x4 v0 = acc[ai][bj][m][0], v1 = acc[ai][bj][m][1];
                        u32x4 w; w.x = cvt_pk_bf16(v0[0], v0[1]); w.y = cvt_pk_bf16(v0[2], v0[3]); w.z = cvt_pk_bf16(v1[0], v1[1]); w.w = cvt_pk_bf16(v1[2], v1[3]);
                        *(u32x4*)(mp + bj * HALF) = w; } }
        }
    }
};
struct BranchOrder {
    StaticOrder so; int rtm; const bf16_t* proj; PG8_LAS unsigned char* junk; int tid;
    __host__ __device__ void init(int M, int G_, int c_, int rtm_) { so.init(M, 1024, G_, c_); rtm = rtm_; }
    __host__ __device__ bool next(int i, Unit& u) const { Unit t; if (!so.next(i >> 2, t)) return false; const int X = i & 3; u.pm = t.pm + X * rtm; u.pn = t.pn + 4 * X; return true; }
    __device__ __forceinline__ void a_ready(const Unit&) const {}
    __device__ __forceinline__ void done(const Unit&) const {}
};
struct SameOrder : StaticOrder {
    __host__ __device__ bool next(int i, Unit& u) const { const bool r = StaticOrder::next(i, u); u.pm = 0; u.pn = 0; return r; }
};
template <class Epi, class Sched, bool ALIGN_EPI = false, bool SP2 = false>
__device__ __forceinline__ void gemm_phase(PG8_LAS unsigned char* lds, const Gemm g, const Sched& S, const Epi& E) {
    int tid_ = threadIdx.x; asm volatile("" : "+v"(tid_));
    const int tid = tid_, wid = __builtin_amdgcn_readfirstlane(tid >> 6), lane = tid & 63, wr = wid >> 2, wc = wid & 3, fr = lane & 15, fq = lane >> 4;
    const int K = g.K, nt = K / BK;
    unsigned voffA[2], voffB[2];
#pragma unroll
    for (int i = 0; i < 2; ++i) { int R, C; stage_rc(tid * 16 + i * 8192, R, C); const int Rb = Epi::PERM ? ((R & ~31) + perm32(R & 31)) : R;
        voffA[i] = (unsigned)(R * K + C) * 2u; voffB[i] = (unsigned)(Rb * K + C) * 2u; }
    const size_t kstep = (size_t)(BK * 2);
    const size_t hstep = (size_t)HALF * K * 2;
    const size_t tstep = 2 * hstep;
    const unsigned ldsw = (unsigned)wid * 1024u;
    const int aoff = lds_byte(wr * 64 + fr, fq * 8), boff = lds_byte(wc * 32 + fr, fq * 8);
#define PG8_SA(b, h) (((b) * 2 + (h)) * HTB)
#define PG8_SB(b, h) ((4 + (b) * 2 + (h)) * HTB)
#define PG8_STAGE(bufoff, gbase, voff) do { _Pragma("unroll") for (int _i = 0; _i < 2; ++_i) \
        __builtin_amdgcn_global_load_lds((const unsigned*)((const char*)(gbase) + (voff)[_i]), (PG8_LAS unsigned*)(lds + (bufoff) + ldsw + _i * 8192), 16, 0, 0); } while (0)
#define PG8_LDA(dst, b, h) do { _Pragma("unroll") for (int m = 0; m < 4; ++m) _Pragma("unroll") for (int k = 0; k < 2; ++k) dst[m][k] = *(const PG8_LAS bf16x8*)(lds + PG8_SA(b, h) + aoff + m * 2048 + k * 1024); } while (0)
#define PG8_LDB(dst, b, h) do { _Pragma("unroll") for (int n = 0; n < 2; ++n) _Pragma("unroll") for (int k = 0; k < 2; ++k) dst[n][k] = *(const PG8_LAS bf16x8*)(lds + PG8_SB(b, h) + boff + n * 2048 + k * 1024); } while (0)
#define PG8_MMA(ai, bj, At, Bt) do { __builtin_amdgcn_s_setprio(1); _Pragma("unroll") for (int m = 0; m < 4; ++m) _Pragma("unroll") for (int n = 0; n < 2; ++n) _Pragma("unroll") for (int k = 0; k < 2; ++k) \
        acc[ai][bj][m][n] = __builtin_amdgcn_mfma_f32_16x16x32_bf16(Bt[n][k], At[m][k], acc[ai][bj][m][n], 0, 0, 0); __builtin_amdgcn_s_setprio(0); } while (0)
#define PG8_WAIT_V(n) asm volatile("s_waitcnt vmcnt(" #n ")" ::: "memory")
#define PG8_WAIT_L(n) asm volatile("s_waitcnt lgkmcnt(" #n ")" ::: "memory")
#define PG8_BAR __builtin_amdgcn_s_barrier()
#define PG8_SCHED __builtin_amdgcn_sched_barrier(0)
    Unit cur, nxt; int ui = 0;
    if (!S.next(0, cur)) return;
    f32x4 acc[2][2][4][2];
#pragma unroll
    for (int a = 0; a < 2; ++a)
#pragma unroll
        for (int b = 0; b < 2; ++b)
#pragma unroll
            for (int m = 0; m < 4; ++m)
#pragma unroll
                for (int n = 0; n < 2; ++n) acc[a][b][m][n] = (f32x4){0.f, 0.f, 0.f, 0.f};
    bf16x8 At[4][2], B0[2][2], B1[2][2];
    const char* cA = (const char*)g.A + (size_t)cur.pm * tstep; const char* cB = (const char*)g.Bt + (size_t)cur.pn * tstep;
    S.a_ready(cur);
    if constexpr (SP2) {
        PG8_STAGE(PG8_SB(0, 0), cB, voffB); PG8_STAGE(PG8_SB(0, 1), cB + hstep, voffB); PG8_STAGE(PG8_SA(0, 0), cA, voffA); PG8_STAGE(PG8_SA(0, 1), cA + hstep, voffA);
        if (wr == 1) PG8_BAR;
        PG8_WAIT_V(2); PG8_BAR;
        PG8_STAGE(PG8_SB(1, 0), cB + kstep, voffB); PG8_STAGE(PG8_SA(1, 0), cA + kstep, voffA); PG8_STAGE(PG8_SB(1, 1), cB + hstep + kstep, voffB);
        PG8_WAIT_V(6); PG8_BAR;
    } else {
        PG8_STAGE(PG8_SB(0, 0), cB, voffB); PG8_STAGE(PG8_SA(0, 0), cA, voffA); PG8_STAGE(PG8_SB(0, 1), cB + hstep, voffB); PG8_STAGE(PG8_SA(0, 1), cA + hstep, voffA);
        if (wr == 1) PG8_BAR;
        PG8_WAIT_V(4); PG8_BAR;
        PG8_STAGE(PG8_SB(1, 0), cB + kstep, voffB); PG8_STAGE(PG8_SA(1, 0), cA + kstep, voffA); PG8_STAGE(PG8_SB(1, 1), cB + hstep + kstep, voffB);
        PG8_WAIT_V(6); PG8_BAR;
    }
    for (;;) {
        const bool has_next = S.next(ui + 1, nxt);
        const char* nA = has_next ? (const char*)g.A + (size_t)nxt.pm * tstep : cA; const char* nB = has_next ? (const char*)g.Bt + (size_t)nxt.pn * tstep : cB;
        for (int t = 0; t < nt; t += 2) {
            const bool last = (t == nt - 2);
            const char* a1 = cA + (size_t)(t + 1) * kstep;
            const char* a2 = last ? nA : cA + (size_t)(t + 2) * kstep; const char* b2 = last ? nB : cB + (size_t)(t + 2) * kstep;
            const char* a3 = a2 + kstep; const char* b3 = b2 + kstep;
            if (last && has_next) S.a_ready(nxt);
            if constexpr (SP2) {
            PG8_LDB(B0, 0, 0); PG8_LDB(B1, 0, 1); PG8_SCHED; PG8_LDA(At, 0, 0); PG8_STAGE(PG8_SA(1, 1), a1 + hstep, voffA);
            PG8_WAIT_V(8); PG8_WAIT_L(0); PG8_BAR; PG8_MMA(0, 0, At, B0); PG8_MMA(0, 1, At, B1); PG8_BAR; PG8_SCHED;
            PG8_LDA(At, 0, 1); PG8_STAGE(PG8_SB(0, 0), b2, voffB); PG8_STAGE(PG8_SB(0, 1), b2 + hstep, voffB); PG8_STAGE(PG8_SA(0, 0), a2, voffA);
            PG8_WAIT_V(8); PG8_WAIT_L(0); PG8_BAR; PG8_MMA(1, 0, At, B0); PG8_MMA(1, 1, At, B1); PG8_BAR; PG8_SCHED;
            PG8_LDB(B0, 1, 0); PG8_LDB(B1, 1, 1); PG8_SCHED; PG8_LDA(At, 1, 0); PG8_STAGE(PG8_SA(0, 1), a2 + hstep, voffA);
            PG8_WAIT_V(8); PG8_WAIT_L(0); PG8_BAR; PG8_MMA(0, 0, At, B0); PG8_MMA(0, 1, At, B1); PG8_BAR; PG8_SCHED;
            PG8_LDA(At, 1, 1); PG8_STAGE(PG8_SB(1, 0), b3, voffB); PG8_STAGE(PG8_SB(1, 1), b3 + hstep, voffB); PG8_STAGE(PG8_SA(1, 0), a3, voffA);
            PG8_WAIT_V(8); PG8_WAIT_L(0); PG8_BAR; PG8_MMA(1, 0, At, B0); PG8_MMA(1, 1, At, B1); PG8_BAR; PG8_SCHED;
            } else {
            PG8_LDB(B0, 0, 0); PG8_SCHED; PG8_LDA(At, 0, 0); PG8_STAGE(PG8_SA(1, 1), a1 + hstep, voffA);
            PG8_WAIT_L(8); PG8_BAR; PG8_WAIT_L(0); PG8_MMA(0, 0, At, B0); PG8_BAR; PG8_SCHED;
            PG8_LDB(B1, 0, 1); PG8_STAGE(PG8_SB(0, 0), b2, voffB);
            PG8_BAR; PG8_WAIT_L(0); PG8_MMA(0, 1, At, B1); PG8_BAR;
            PG8_LDA(At, 0, 1); PG8_STAGE(PG8_SA(0, 0), a2, voffA);
            PG8_BAR; PG8_WAIT_L(0); PG8_MMA(1, 0, At, B0); PG8_BAR; PG8_SCHED;
            PG8_STAGE(PG8_SB(0, 1), b2 + hstep, voffB);
            PG8_WAIT_V(6); PG8_BAR; PG8_MMA(1, 1, At, B1); PG8_BAR;
            PG8_LDB(B0, 1, 0); PG8_SCHED; PG8_LDA(At, 1, 0); PG8_STAGE(PG8_SA(0, 1), a2 + hstep, voffA);
            PG8_WAIT_L(8); PG8_BAR; PG8_WAIT_L(0); PG8_MMA(0, 0, At, B0); PG8_BAR; PG8_SCHED;
            PG8_LDB(B1, 1, 1); PG8_STAGE(PG8_SB(1, 0), b3, voffB);
            PG8_BAR; PG8_WAIT_L(0); PG8_MMA(0, 1, At, B1); PG8_BAR;
            PG8_LDA(At, 1, 1); PG8_STAGE(PG8_SA(1, 0), a3, voffA);
            PG8_BAR; PG8_WAIT_L(0); PG8_MMA(1, 0, At, B0); PG8_BAR; PG8_SCHED;
            PG8_STAGE(PG8_SB(1, 1), b3 + hstep, voffB);
            PG8_WAIT_V(6); PG8_BAR; PG8_MMA(1, 1, At, B1); PG8_BAR;
            }
        }
        if constexpr (ALIGN_EPI) { if (wr == 0) PG8_BAR; }
        if constexpr (Epi::CHAIN) { E.chain(acc, cur, wr, wc, fr, fq); S.done(cur); } else
        if constexpr (!Epi::AFTER_DRAIN) { E(acc, cur, wr, wc, fr, fq);
#if defined(PROBE_EPI2)
            if constexpr (Epi::PROBE2) { asm volatile("" ::: "memory"); E(acc, cur, wr, wc, fr, fq); }
#endif
            S.done(cur); }
        if (!has_next) break;
        bool zero_acc = true; if constexpr (Epi::CHAIN) zero_acc = E.last(cur);
        if (zero_acc)
#pragma unroll
        for (int a = 0; a < 2; ++a)
#pragma unroll
            for (int b = 0; b < 2; ++b)
#pragma unroll
                for (int m = 0; m < 4; ++m)
#pragma unroll
                    for (int n = 0; n < 2; ++n) acc[a][b][m][n] = (f32x4){0.f, 0.f, 0.f, 0.f};
        cur = nxt; cA = nA; cB = nB; ++ui;
        if constexpr (ALIGN_EPI) { if (wr == 1) PG8_BAR; }
    }
    PG8_WAIT_V(0);
    if constexpr (!ALIGN_EPI) { if (wr == 0) PG8_BAR; }
    PG8_BAR;
    if constexpr (Epi::AFTER_DRAIN) { E.fused(acc, cur, wr, wc, fr, fq, lds, wid, lane); S.done(cur); }
#undef PG8_SA
#undef PG8_SB
#undef PG8_STAGE
#undef PG8_LDA
#undef PG8_LDB
#undef PG8_MMA
#undef PG8_WAIT_V
#undef PG8_WAIT_L
#undef PG8_BAR
#undef PG8_SCHED
}
}
#ifndef PG8_SP2
#define PG8_SP2 true
#endif
#ifndef PG8_ALIGN
#define PG8_ALIGN true
#endif
#ifndef MK_PER_PHASE
#define MK_PER_PHASE 0
#endif

constexpr int DM = 1024, NIN = 10240, WBR = 512, DEPTH = 2;
constexpr int MP = 65536, MS = 512, MT = MP + MS;
constexpr int NTP = MP / 256;
constexpr float EPS = 1e-6f;
constexpr int PP = 4096, C_AU = 0, C_AV = 512, C_BA = 1024, C_BZ = 1536, C_CX = 2048, C_CZ = 2560, C_DB = 3072, C_DC = 3584;
constexpr size_t O_Y = 0, O_CONVP = (size_t)MT * DM, O_POOLP = O_CONVP + 2 * 16 * 30 * 512, O_SHORTP = O_POOLP + 2 * 16 * 15 * 512, O_CONVS = O_SHORTP + 2 * 16 * 2 * 512,
                 O_POOLS = O_CONVS + 2 * 8 * 30 * 512, O_SHORTS = O_POOLS + 2 * 8 * 15 * 512, O_VS = O_SHORTS + 2 * 8 * 2 * 512, O_END = O_VS + 2 * 8 * 64 * 512;
constexpr size_t MiB = 1u << 20;
constexpr size_t WS_CTL = 0, CTL_ZERO_BYTES = 1 * MiB;
constexpr size_t WS_WIN = 2 * MiB, WS_WB = 42 * MiB, WS_WO = 50 * MiB, WS_PW = 54 * MiB, WS_WSB = 54 * MiB + 512 * 1024, WS_H = 56 * MiB;
__host__ __device__ constexpr size_t ws_need(int rtm) { return WS_H + (size_t)rtm * 256 * (1024 + 2048 + 4096 + 1024) * 2; }

constexpr int LDS_BYTES = 163840;
constexpr int NWAVES = 8;

#define LAS __attribute__((address_space(3)))
typedef unsigned short bf16;
typedef unsigned v4u __attribute__((ext_vector_type(4)));
typedef unsigned v2u __attribute__((ext_vector_type(2)));
typedef float f32x4 __attribute__((ext_vector_type(4)));
typedef short bf16x8 __attribute__((ext_vector_type(8)));
#define LDS_WAIT() asm volatile("s_waitcnt lgkmcnt(0)" ::: "memory")
__device__ __forceinline__ unsigned f2bf(float f) { unsigned u = __builtin_bit_cast(unsigned, f); return (u + 0x7fffu + ((u >> 16) & 1u)) >> 16; }
__device__ __forceinline__ unsigned pk2(float lo, float hi) { unsigned r; asm("v_cvt_pk_bf16_f32 %0, %1, %2" : "=v"(r) : "v"(lo), "v"(hi)); return r; }
using pg8::bflo; using pg8::bfhi; using pg8::fast_sigmoid; using pg8::fast_silu;
__device__ __forceinline__ void unpack8(const v4u w, float (&v)[8]) { v[0] = bflo(w.x); v[1] = bfhi(w.x); v[2] = bflo(w.y); v[3] = bfhi(w.y); v[4] = bflo(w.z); v[5] = bfhi(w.z); v[6] = bflo(w.w); v[7] = bfhi(w.w); }
__device__ __forceinline__ v4u pack8(const float (&v)[8]) { v4u w; w.x = pk2(v[0], v[1]); w.y = pk2(v[2], v[3]); w.z = pk2(v[4], v[5]); w.w = pk2(v[6], v[7]); return w; }
__device__ __forceinline__ float dpp_add(float v, int) { return v; }
template <int CTRL> __device__ __forceinline__ float dpp_mov(float v) { return __builtin_bit_cast(float, __builtin_amdgcn_update_dpp(0, __builtin_bit_cast(int, v), CTRL, 0xf, 0xf, true)); }
__device__ __forceinline__ float wave_sum(float v) {
    v += dpp_mov<0xB1>(v);
    v += dpp_mov<0x4E>(v);
    v += dpp_mov<0x141>(v);
    v += dpp_mov<0x140>(v);
    const int iv = __builtin_bit_cast(int, v);
    const float r0 = __builtin_bit_cast(float, __builtin_amdgcn_readlane(iv, 0)), r1 = __builtin_bit_cast(float, __builtin_amdgcn_readlane(iv, 16)),
                r2 = __builtin_bit_cast(float, __builtin_amdgcn_readlane(iv, 32)), r3 = __builtin_bit_cast(float, __builtin_amdgcn_readlane(iv, 48));
    return (r0 + r1) + (r2 + r3);
}
typedef short v4i16_t __attribute__((ext_vector_type(4)));

struct Args { const float* in[22]; float* out; unsigned char* ws; int ph_lo, ph_hi, nsc, pad; };
typedef const __attribute__((address_space(4))) Args* ArgP;
struct Frame {
    LAS unsigned char* lds;
    int tid, lane, wave, vcu, G;
    float* out; unsigned char* ws;
    int l, sc_row0, R, rtm;
    bf16 *H, *OUTS, *PROJ, *X1;
    unsigned char* G8;
};
enum { I_XP = 0, I_XS, I_SCONV, I_SPOOL, I_SSHORT, I_GPRE, I_GPOST, I_WIN, I_BGATE, I_LNVG, I_LNVB, I_WS, I_BS, I_CONVW, I_CONVB, I_LNBG, I_LNBB, I_POOLW, I_PSCALE, I_CONVDW, I_WBR, I_WOUT };

__device__ __forceinline__ int gate_dst(int c) { if (c >= 6144) return c; const int part = c >> 9, k = (c >> 7) & 3, j = c & 127;
    switch (part) { case 0: return 256 * k + j; case 2: return 256 * k + 128 + j; case 1: return 1024 + (c & 511); case 3: return 1536 + 256 * k + j; case 4: return 1536 + 256 * k + 128 + j; case 8: return 4096 + 256 * k + j; case 11: return 4096 + 256 * k + 128 + j;
                    case 9: return 5120 + 256 * k + j; case 10: return 5120 + 256 * k + 128 + j; default: return c; } }
template <bool GATEPERM = false>
__device__ __forceinline__ void transpose_item(const float* W, int K, int N, bf16* WT, LAS float* scr, int item, int lane, const float* rowscale = nullptr) {
    const int nblk = N / 32, kb = item / nblk, nb = item % nblk, k0 = 64 * kb, n0 = 32 * nb;
#pragma unroll 8
    for (int i = 0; i < 32; ++i) { const int kk = 2 * i + (lane >> 5); scr[kk * 33 + (lane & 31)] = W[(size_t)(k0 + kk) * N + n0 + (lane & 31)]; }
    LDS_WAIT(); asm volatile("" ::: "memory");
    const int c = lane & 7;
#pragma unroll
    for (int j = 0; j < 4; ++j) { const int n = (lane >> 3) + 8 * j; const LAS float* s = scr + (8 * c) * 33 + n;
        const float rs = rowscale ? rowscale[n0 + n] : 1.0f;
        v4u o; o.x = pk2(s[0 * 33] * rs, s[1 * 33] * rs); o.y = pk2(s[2 * 33] * rs, s[3 * 33] * rs); o.z = pk2(s[4 * 33] * rs, s[5 * 33] * rs); o.w = pk2(s[6 * 33] * rs, s[7 * 33] * rs);
        const int drow = GATEPERM ? gate_dst(n0 + n) : (n0 + n);
        *(v4u*)(WT + (size_t)drow * K + k0 + 8 * c) = o; }
    LDS_WAIT(); asm volatile("" ::: "memory");
}
__device__ __forceinline__ const float* xin_row(const Frame& F, ArgP A, int m) { return m < MP ? A->in[I_XP] + (size_t)m * DM : A->in[I_XS] + (size_t)(m - MP) * DM; }
__device__ __forceinline__ void prenorm_row(const Frame& F, ArgP A, const float* xrow, const float* g, bf16* hrow) {
    f32x4 v[4]; float s = 0.f;
#pragma unroll
    for (int i = 0; i < 2; ++i) { v[2 * i] = *(const f32x4*)(xrow + 8 * F.lane + 512 * i); v[2 * i + 1] = *(const f32x4*)(xrow + 8 * F.lane + 512 * i + 4); }
#pragma unroll
    for (int i = 0; i < 4; ++i) s += (v[i].x * v[i].x + v[i].y * v[i].y) + (v[i].z * v[i].z + v[i].w * v[i].w);
    const float r = rsqrtf(wave_sum(s) * (1.f / DM) + EPS);
#pragma unroll
    for (int i = 0; i < 2; ++i) { const f32x4 g0 = *(const f32x4*)(g + 8 * F.lane + 512 * i), g1 = *(const f32x4*)(g + 8 * F.lane + 512 * i + 4);
        const f32x4 a = v[2 * i] * r * g0, b = v[2 * i + 1] * r * g1; v4u o; o.x = pk2(a.x, a.y); o.y = pk2(a.z, a.w); o.z = pk2(b.x, b.y); o.w = pk2(b.z, b.w);
        *(v4u*)(hrow + 8 * F.lane + 512 * i) = o; }
}
__device__ __forceinline__ void prenorm_rows(Frame& F, ArgP A, int row0, int nrows, bf16* H) {
    const int gw = F.vcu * NWAVES + F.wave, NGW = F.G * NWAVES;
#pragma unroll 1
    for (int r0 = gw; r0 < nrows; r0 += 2 * NGW) {
        f32x4 v[2][4];
#pragma unroll
        for (int u = 0; u < 2; ++u) { const int rq = r0 + u * NGW; const float* xrow = xin_row(F, A, row0 + (rq < nrows ? rq : r0));
#pragma unroll
            for (int i = 0; i < 2; ++i) { v[u][2 * i] = *(const f32x4*)(xrow + 8 * F.lane + 512 * i); v[u][2 * i + 1] = *(const f32x4*)(xrow + 8 * F.lane + 512 * i + 4); } }
#pragma unroll
        for (int u = 0; u < 2; ++u) { const int r = r0 + u * NGW; if (r < nrows) { float s = 0.f;
#pragma unroll
            for (int i = 0; i < 4; ++i) s += (v[u][i].x * v[u][i].x + v[u][i].y * v[u][i].y) + (v[u][i].z * v[u][i].z + v[u][i].w * v[u][i].w);
            const float rr = rsqrtf(wave_sum(s) * (1.f / DM) + EPS); const float* g = A->in[I_GPRE]; bf16* hrow = H + (size_t)r * DM;
#pragma unroll
            for (int i = 0; i < 2; ++i) { const f32x4 g0 = *(const f32x4*)(g + 8 * F.lane + 512 * i), g1 = *(const f32x4*)(g + 8 * F.lane + 512 * i + 4);
                const f32x4 a = v[u][2 * i] * rr * g0, b = v[u][2 * i + 1] * rr * g1; v4u o; o.x = pk2(a.x, a.y); o.y = pk2(a.z, a.w); o.z = pk2(b.x, b.y); o.w = pk2(b.z, b.w);
                *(v4u*)(hrow + 8 * F.lane + 512 * i) = o; } } }
    }
}
__device__ __forceinline__ void phase_prep(Frame& F, ArgP A, int sc0_rows) {
    LAS float* scr = (LAS float*)(F.lds + F.wave * 16384);
    const int gw = F.vcu * NWAVES + F.wave, NGW = F.G * NWAVES;
    bf16* win_t = (bf16*)(F.ws + WS_WIN); bf16* wb_t = (bf16*)(F.ws + WS_WB); bf16* wo_t = (bf16*)(F.ws + WS_WO); bf16* pw_t = (bf16*)(F.ws + WS_PW); bf16* ws_b = (bf16*)(F.ws + WS_WSB);
    constexpr int I_IN = (DM / 64) * (NIN / 32), I_BR = (WBR / 64) * (DM / 32), I_OUT = (DM / 64) * (DM / 32), I_PW = (128 / 64) * (128 / 32);
    constexpr int NITEMS = 2 * I_IN + 8 * I_BR + 2 * I_OUT + 8 * I_PW;
    for (int it = gw; it < NITEMS; it += NGW) {
        int r = it;
        if (r < 2 * I_IN) { const int l = r / I_IN; transpose_item<true>(A->in[I_WIN] + (size_t)l * DM * NIN, DM, NIN, win_t + (size_t)l * NIN * DM, scr, r % I_IN, F.lane); continue; } r -= 2 * I_IN;
        if (r < 8 * I_BR) { const int q = r / I_BR; transpose_item(A->in[I_WBR] + (size_t)q * WBR * DM, WBR, DM, wb_t + (size_t)q * DM * WBR, scr, r % I_BR, F.lane); continue; } r -= 8 * I_BR;
        if (r < 2 * I_OUT) { const int l = r / I_OUT; transpose_item(A->in[I_WOUT] + (size_t)l * DM * DM, DM, DM, wo_t + (size_t)l * DM * DM, scr, r % I_OUT, F.lane); continue; } r -= 2 * I_OUT;
        { const int q = r / I_PW; transpose_item(A->in[I_POOLW] + (size_t)q * 128 * 128, 128, 128, pw_t + (size_t)q * 128 * 128, scr, r % I_PW, F.lane, A->in[I_PSCALE] + (size_t)q * 128); }
    }
    for (int i = (F.vcu * NWAVES * 64 + F.tid); i < 2 * 4 * 128 * 128; i += F.G * NWAVES * 64) { const int s = i & 127, t = (i >> 7) & 127; ws_b[i] = (bf16)(s <= t ? f2bf(A->in[I_WS][i]) : 0u); }
    prenorm_rows(F, A, 0, sc0_rows, (bf16*)(F.ws + WS_H));
}

struct RowBlk { int m0, b, t0; bool smp, first, last; };
__device__ __forceinline__ RowBlk row_blk(int m0) { RowBlk r; r.m0 = m0; r.smp = m0 >= MP; r.b = r.smp ? (m0 - MP) >> 6 : m0 >> 12; r.t0 = r.smp ? 0 : (m0 & 4095); r.first = r.t0 == 0; r.last = r.smp ? true : (r.t0 == 4096 - 64); return r; }

__device__ __forceinline__ void mix_A(Frame& F, ArgP A, const int mc, const int ns) {
    const int l = F.l, lane = F.lane, fr = lane & 15, fq = lane >> 4;
    const bool smp = mc >= MP; const int sb_ = smp ? (mc - MP) >> 6 : 0;
    const bf16* Pc = F.PROJ + (size_t)(mc - F.sc_row0) * PP;
    LAS bf16* vN = (LAS bf16*)F.lds;
    {
        float g8[8], b8[8];
#pragma unroll
        for (int i = 0; i < 8; ++i) { g8[i] = A->in[I_LNVG][l * 512 + 8 * lane + i]; b8[i] = A->in[I_LNVB][l * 512 + 8 * lane + i]; }
#pragma unroll 1
        for (int sb = 0; sb < ns; sb += 64) {
            v4u raw[8];
#pragma unroll
            for (int j = 0; j < 8; ++j) raw[j] = *(const v4u*)(Pc + (size_t)(sb + F.wave + 8 * j) * PP + C_AV + 8 * lane);
#pragma unroll
            for (int j = 0; j < 8; ++j) { const int s = sb + F.wave + 8 * j;
                float v[8]; unpack8(raw[j], v);
                float sum = 0.f;
#pragma unroll
                for (int i = 0; i < 8; ++i) sum += v[i];
                const float mean = wave_sum(sum) * (1.f / 512.f); float q = 0.f;
#pragma unroll
                for (int i = 0; i < 8; ++i) { v[i] -= mean; q += v[i] * v[i]; }
                const float rstd = rsqrtf(wave_sum(q) * (1.f / 512.f) + EPS);
#pragma unroll
                for (int i = 0; i < 8; ++i) v[i] = v[i] * rstd * g8[i] + b8[i];
                if (smp) { float* o = F.out + O_VS + ((size_t)(l * 8 + sb_) * 64 + s) * 512 + 8 * lane; *(f32x4*)o = (f32x4){v[0], v[1], v[2], v[3]}; *(f32x4*)(o + 4) = (f32x4){v[4], v[5], v[6], v[7]}; }
                *(LAS v4u*)(vN + s * 528 + 8 * lane) = pack8(v);
            }
        }
    }
    __syncthreads();
    const int head = F.wave >> 1, cb0 = F.wave * 4;
    LAS bf16* Zs = vN + 64 * 528;
#pragma unroll 1
    for (int hh = 0; hh < (ns >> 6); ++hh) {
    const int half = (ns >> 6) - 1 - hh;
    const int m0 = mc + 64 * half;
    const bf16* W = (const bf16*)(F.ws + WS_WSB) + ((size_t)(l * 4 + head) * 128 + 64 * half) * 128;
    f32x4 acc[4][4];
#pragma unroll
    for (int a = 0; a < 4; ++a)
#pragma unroll
        for (int b = 0; b < 4; ++b) acc[a][b] = (f32x4){0.f, 0.f, 0.f, 0.f};
    const int nks = 2 + 2 * half;
    for (int ks = 0; ks < nks; ++ks) {
        bf16x8 xf[4], yf[4];
#pragma unroll
        for (int cb = 0; cb < 4; ++cb) { const LAS bf16* bp = vN + (ks * 32 + 8 * fq + (fr >> 2)) * 528 + (cb0 + cb) * 16 + 4 * (fr & 3);
            const v4i16_t lo = __builtin_amdgcn_ds_read_tr16_b64_v4i16((LAS v4i16_t*)bp), hi = __builtin_amdgcn_ds_read_tr16_b64_v4i16((LAS v4i16_t*)(bp + 4 * 528));
            xf[cb] = (bf16x8){lo.x, lo.y, lo.z, lo.w, hi.x, hi.y, hi.z, hi.w}; }
#pragma unroll
        for (int tb = 0; tb < 4; ++tb) yf[tb] = *(const bf16x8*)(W + (size_t)(tb * 16 + fr) * 128 + ks * 32 + fq * 8);
#pragma unroll
        for (int cb = 0; cb < 4; ++cb)
#pragma unroll
            for (int tb = 0; tb < 4; ++tb) acc[cb][tb] = __builtin_amdgcn_mfma_f32_16x16x32_bf16(xf[cb], yf[tb], acc[cb][tb], 0, 0, 0);
    }
    bf16* Oa = F.OUTS;
    {
        v4u ar[8]; float bsv[4];
#pragma unroll
        for (int j = 0; j < 8; ++j) ar[j] = *(const v4u*)(F.PROJ + (size_t)(m0 + F.wave + 8 * j - F.sc_row0) * PP + C_AU + 8 * lane);
#pragma unroll
        for (int tb = 0; tb < 4; ++tb) bsv[tb] = A->in[I_BS][(l * 4 + head) * 128 + 64 * half + tb * 16 + fr];
        __syncthreads();
#pragma unroll
        for (int j = 0; j < 8; ++j) *(LAS v4u*)(Zs + (F.wave + 8 * j) * 520 + 8 * lane) = ar[j];
        __syncthreads();
#pragma unroll
        for (int tb = 0; tb < 4; ++tb) { const int t = tb * 16 + fr; const size_t row = (size_t)(m0 + t - F.sc_row0); const float bs = bsv[tb];
#pragma unroll
            for (int cb = 0; cb < 4; ++cb) { const int c = (cb0 + cb) * 16 + 4 * fq; const v2u u = *(const LAS v2u*)(Zs + t * 520 + c); const f32x4 a = acc[cb][tb];
                v2u o; o.x = pk2(bflo(u.x) * (a[0] + bs), bfhi(u.x) * (a[1] + bs));
                o.y = pk2(bflo(u.y) * (a[2] + bs), bfhi(u.y) * (a[3] + bs));
                *(v2u*)(Oa + row * 512 + c) = o; } }
    }
    }
    __syncthreads();
}

__device__ __forceinline__ void mix_B(Frame& F, ArgP A, const RowBlk rb) {
    const int l = F.l, lane = F.lane;
    LAS bf16* G = (LAS bf16*)F.lds;
    const int nb = rb.smp ? 8 : 16;
#pragma unroll
    for (int jb = 0; jb < 12; jb += 6) {
        v4u ra[6];
#pragma unroll
        for (int j = 0; j < 6; ++j) { const int r = F.wave + 8 * (jb + j); int tl = r - 30; tl = tl > 63 ? 63 : tl; if (rb.first && tl < 0) tl = 0;
            const bf16* pr = F.PROJ + (size_t)(rb.m0 + tl - F.sc_row0) * PP; ra[j] = *(const v4u*)(pr + C_BA + 8 * lane); }
#pragma unroll
        for (int j = 0; j < 6; ++j) { const int r = F.wave + 8 * (jb + j); const int tl = r - 30;
            if (r < 94) {
                float glu[8];
                if (tl < 0 && rb.first) {
                    if (rb.smp) { const float* sp = A->in[I_SCONV] + ((size_t)(l * 8 + rb.b) * 30 + r) * 512 + 8 * lane; const f32x4 a = *(const f32x4*)sp, b = *(const f32x4*)(sp + 4);
                        glu[0] = a.x; glu[1] = a.y; glu[2] = a.z; glu[3] = a.w; glu[4] = b.x; glu[5] = b.y; glu[6] = b.z; glu[7] = b.w; }
                    else {
#pragma unroll
                        for (int i = 0; i < 8; ++i) glu[i] = 0.f; }
                } else {
                    unpack8(ra[j], glu);
                }
                *(LAS v4u*)(G + r * 512 + 8 * lane) = pack8(glu);
                if (rb.last && tl >= 34) { float* o = F.out + (rb.smp ? O_CONVS : O_CONVP) + ((size_t)(l * nb + rb.b) * 30 + (tl - 34)) * 512 + 8 * lane;
                    *(f32x4*)o = (f32x4){glu[0], glu[1], glu[2], glu[3]}; *(f32x4*)(o + 4) = (f32x4){glu[4], glu[5], glu[6], glu[7]}; }
            }
        }
    }
    __syncthreads();
    const int c = F.tid;
    LAS float* CBp = (LAS float*)(F.lds + 96256);
    float w[31];
#pragma unroll
    for (int k = 0; k < 31; ++k) w[k] = A->in[I_CONVW][(l * 31 + k) * 512 + c];
    const float bias = A->in[I_CONVB][l * 512 + c];
    const f32x4 g0 = *(const f32x4*)(A->in[I_LNBG] + l * 512 + 4 * lane), g1 = *(const f32x4*)(A->in[I_LNBG] + l * 512 + 256 + 4 * lane);
    const f32x4 b0 = *(const f32x4*)(A->in[I_LNBB] + l * 512 + 4 * lane), b1 = *(const f32x4*)(A->in[I_LNBB] + l * 512 + 256 + 4 * lane);
    bf16* Ob = F.OUTS + (size_t)F.rtm * 256 * 512;
#pragma unroll 1
    for (int rg = 0; rg < 2; ++rg) {
        v2u zq[4][2];
#pragma unroll
        for (int i = 0; i < 4; ++i) { const size_t row = (size_t)(rb.m0 + rg * 32 + F.wave * 4 + i - F.sc_row0); zq[i][0] = *(const v2u*)(F.PROJ + row * PP + C_BZ + 4 * lane); zq[i][1] = *(const v2u*)(F.PROJ + row * PP + C_BZ + 256 + 4 * lane); }
        {
            float x[62];
#pragma unroll
            for (int j = 0; j < 62; ++j) x[j] = __uint_as_float((unsigned)G[(rg * 32 + j) * 512 + c] << 16);
#pragma unroll
            for (int i = 0; i < 32; ++i) { float s = bias;
#pragma unroll
                for (int k = 0; k < 31; ++k) s += x[i + k] * w[k];
                CBp[i * 512 + c] = s; }
        }
        __syncthreads();
#pragma unroll
        for (int i = 0; i < 4; ++i) { const int ti = F.wave * 4 + i, t = rg * 32 + ti; const size_t row = (size_t)(rb.m0 + t - F.sc_row0);
            f32x4 v0 = *(const LAS f32x4*)(CBp + ti * 512 + 4 * lane), v1 = *(const LAS f32x4*)(CBp + ti * 512 + 256 + 4 * lane);
            const float mean = wave_sum((v0.x + v0.y) + (v0.z + v0.w) + (v1.x + v1.y) + (v1.z + v1.w)) * (1.f / 512.f);
            v0 = v0 - mean; v1 = v1 - mean;
            const float rstd = rsqrtf(wave_sum((v0.x * v0.x + v0.y * v0.y) + (v0.z * v0.z + v0.w * v0.w) + (v1.x * v1.x + v1.y * v1.y) + (v1.z * v1.z + v1.w * v1.w)) * (1.f / 512.f) + EPS);
            v0 = v0 * rstd * g0 + b0; v1 = v1 * rstd * g1 + b1;
            const v2u z0 = zq[i][0], z1 = zq[i][1];
            v2u q0, q1;
            q0.x = pk2(fast_silu(v0.x) * bflo(z0.x), fast_silu(v0.y) * bfhi(z0.x)); q0.y = pk2(fast_silu(v0.z) * bflo(z0.y), fast_silu(v0.w) * bfhi(z0.y));
            q1.x = pk2(fast_silu(v1.x) * bflo(z1.x), fast_silu(v1.y) * bfhi(z1.x)); q1.y = pk2(fast_silu(v1.z) * bflo(z1.y), fast_silu(v1.w) * bfhi(z1.y));
            *(v2u*)(Ob + row * 512 + 4 * lane) = q0; *(v2u*)(Ob + row * 512 + 256 + 4 * lane) = q1; }
        __syncthreads();
    }
}

__device__ __forceinline__ void mix_C(Frame& F, ArgP A, const RowBlk rb) {
    const int l = F.l, lane = F.lane, fr = lane & 15, fq = lane >> 4;
    LAS bf16* Pp = (LAS bf16*)F.lds;
    LAS bf16* Xs = (LAS bf16*)(F.lds + 69632);
    const int nb = rb.smp ? 8 : 16;
#pragma unroll
    for (int jb = 0; jb < 10; jb += 5) {
        v4u rv[5];
#pragma unroll
        for (int j = 0; j < 5; ++j) { const int r = F.wave + 8 * (jb + j); int tl = r - 15; tl = tl > 63 ? 63 : tl; if (rb.first && tl < 0) tl = 0;
            rv[j] = *(const v4u*)(F.PROJ + (size_t)(rb.m0 + tl - F.sc_row0) * PP + C_CX + 8 * lane); }
#pragma unroll
        for (int j = 0; j < 5; ++j) { const int r = F.wave + 8 * (jb + j); if (r < 79) *(LAS v4u*)(Xs + r * 512 + 8 * lane) = rv[j]; }
    }
    __syncthreads();
    {
        const int c = F.tid, g = F.wave >> 1;
        float h[15];
#pragma unroll
        for (int j = 0; j < 15; ++j) {
            float x = 0.f;
            if (rb.first) { if (rb.smp) x = A->in[I_SPOOL][((size_t)(l * 8 + rb.b) * 15 + (14 - j)) * 512 + c]; }
            else x = __uint_as_float((unsigned)Xs[(14 - j) * 512 + c] << 16);
            h[j] = x;
        }
        const float wf = (float)(2 << g); const int pos0 = (rb.smp ? 2048 : 0) + rb.t0;
#pragma unroll
        for (int t = 0; t < 64; ++t) {
            const float x = __uint_as_float((unsigned)Xs[(15 + t) * 512 + c] << 16);
            const float s2 = x + h[0], s4 = s2 + h[1] + h[2], s8 = s4 + (h[3] + h[4]) + (h[5] + h[6]), s16 = s8 + ((h[7] + h[8]) + (h[9] + h[10])) + ((h[11] + h[12]) + (h[13] + h[14]));
            const float sum = g == 0 ? s2 : (g == 1 ? s4 : (g == 2 ? s8 : s16));
            const float icnt = __builtin_amdgcn_rcpf(fminf((float)(pos0 + t + 1), wf));
            Pp[t * 520 + c] = (bf16)f2bf(sum * icnt - x);
            if (rb.last && t >= 49) F.out[(rb.smp ? O_POOLS : O_POOLP) + ((size_t)(l * nb + rb.b) * 15 + (t - 49)) * 512 + c] = x;
#pragma unroll
            for (int j = 14; j > 0; --j) h[j] = h[j - 1];
            h[0] = x;
        }
    }
    __syncthreads();
    const int g = F.wave >> 1, db0 = (F.wave & 1) * 4;
    const bf16* X = (const bf16*)(F.ws + WS_PW) + (size_t)(l * 4 + g) * 128 * 128;
    f32x4 acc[4][4];
#pragma unroll
    for (int a = 0; a < 4; ++a)
#pragma unroll
        for (int b = 0; b < 4; ++b) acc[a][b] = (f32x4){0.f, 0.f, 0.f, 0.f};
#pragma unroll
    for (int ks = 0; ks < 4; ++ks) {
        bf16x8 xf[4], yf[4];
#pragma unroll
        for (int db = 0; db < 4; ++db) xf[db] = *(const bf16x8*)(X + (size_t)((db0 + db) * 16 + fr) * 128 + ks * 32 + fq * 8);
#pragma unroll
        for (int tb = 0; tb < 4; ++tb) yf[tb] = *(const LAS bf16x8*)(Pp + (tb * 16 + fr) * 520 + g * 128 + ks * 32 + fq * 8);
#pragma unroll
        for (int db = 0; db < 4; ++db)
#pragma unroll
            for (int tb = 0; tb < 4; ++tb) acc[db][tb] = __builtin_amdgcn_mfma_f32_16x16x32_bf16(xf[db], yf[tb], acc[db][tb], 0, 0, 0);
    }
    bf16* Oc = F.OUTS + (size_t)2 * F.rtm * 256 * 512;
    LAS bf16* Zs = Xs;
    v4u zr[8];
#pragma unroll
    for (int j = 0; j < 8; ++j) zr[j] = *(const v4u*)(F.PROJ + (size_t)(rb.m0 + F.wave + 8 * j - F.sc_row0) * PP + C_CZ + 8 * lane);
#pragma unroll
    for (int j = 0; j < 8; ++j) *(LAS v4u*)(Zs + (F.wave + 8 * j) * 520 + 8 * lane) = zr[j];
    __syncthreads();
#pragma unroll
    for (int db = 0; db < 4; ++db) { const int c = g * 128 + (db0 + db) * 16 + 4 * fq;
#pragma unroll
        for (int tb = 0; tb < 4; ++tb) { const int t = tb * 16 + fr; const size_t row = (size_t)(rb.m0 + t - F.sc_row0); const v2u z = *(const LAS v2u*)(Zs + t * 520 + c); const f32x4 a = acc[db][tb];
            v2u o; o.x = pk2(a[0] * bflo(z.x), a[1] * bfhi(z.x)); o.y = pk2(a[2] * bflo(z.y), a[3] * bfhi(z.y));
            *(v2u*)(Oc + row * 512 + c) = o; } }
    __syncthreads();
}

__device__ __forceinline__ void mix_D(Frame& F, ArgP A, const RowBlk rb) {
    const int l = F.l, lane = F.lane, c = 8 * lane; const int nb = rb.smp ? 8 : 16;
    float w0[8], w1[8], w2[8];
#pragma unroll
    for (int i = 0; i < 8; ++i) { w0[i] = A->in[I_CONVDW][(l * 3 + 0) * 512 + c + i]; w1[i] = A->in[I_CONVDW][(l * 3 + 1) * 512 + c + i]; w2[i] = A->in[I_CONVDW][(l * 3 + 2) * 512 + c + i]; }
    const int tl0 = F.wave * 8;
    float u2[8], u1[8];
    if (tl0 == 0 && rb.first) {
        if (rb.smp) { const float* sp = A->in[I_SSHORT] + ((size_t)(l * 8 + rb.b) * 2) * 512 + c;
#pragma unroll
            for (int i = 0; i < 8; ++i) { u2[i] = sp[i]; u1[i] = sp[512 + i]; } }
        else {
#pragma unroll
            for (int i = 0; i < 8; ++i) { u2[i] = 0.f; u1[i] = 0.f; } }
    } else {
        const bf16* p2 = F.PROJ + (size_t)(rb.m0 + tl0 - 2 - F.sc_row0) * PP; const bf16* p1 = p2 + PP;
        unpack8(*(const v4u*)(p2 + C_DC + c), u2); unpack8(*(const v4u*)(p1 + C_DC + c), u1);
    }
    bf16* Od = F.OUTS + (size_t)3 * F.rtm * 256 * 512;
    v4u q[8][2];
#pragma unroll
    for (int i = 0; i < 8; ++i) { const bf16* pr = F.PROJ + (size_t)(rb.m0 + tl0 + i - F.sc_row0) * PP; q[i][0] = *(const v4u*)(pr + C_DB + c); q[i][1] = *(const v4u*)(pr + C_DC + c); }
#pragma unroll
    for (int i = 0; i < 8; ++i) { asm volatile("" : "+v"(q[i][0])); asm volatile("" : "+v"(q[i][1])); }
#pragma unroll
    for (int i = 0; i < 8; ++i) { const int tl = tl0 + i; const size_t row = (size_t)(rb.m0 + tl - F.sc_row0);
        float dbz[8], u[8], o[8];
        unpack8(q[i][0], dbz); unpack8(q[i][1], u);
#pragma unroll
        for (int k = 0; k < 8; ++k) o[k] = dbz[k] * (u2[k] * w0[k] + u1[k] * w1[k] + u[k] * w2[k]);
        *(v4u*)(Od + row * 512 + c) = pack8(o);
        if (rb.last && tl >= 62) { float* so = F.out + (rb.smp ? O_SHORTS : O_SHORTP) + ((size_t)(l * nb + rb.b) * 2 + (tl - 62)) * 512 + c;
            *(f32x4*)so = (f32x4){u[0], u[1], u[2], u[3]}; *(f32x4*)(so + 4) = (f32x4){u[4], u[5], u[6], u[7]}; }
#pragma unroll
        for (int k = 0; k < 8; ++k) { u2[k] = u1[k]; u1[k] = u[k]; }
    }
}
#ifndef PROBE_MIX_A
#define PROBE_MIX_A 1
#endif
#ifndef PROBE_MIX_B
#define PROBE_MIX_B 1
#endif
#ifndef PROBE_MIX_C
#define PROBE_MIX_C 1
#endif
#ifndef PROBE_MIX_D
#define PROBE_MIX_D 1
#endif
__device__ __forceinline__ void phase_mix(Frame& F, ArgP A) {
    const int nrb = F.R >> 6;
#ifndef DIS_B
#pragma unroll 1
    for (int rp = 0; rp < PROBE_MIX_B; ++rp)
#pragma unroll 1
    for (int t = (F.vcu + F.G - (0 * nrb) % F.G) % F.G; t < nrb; t += F.G) mix_B(F, A, row_blk(F.sc_row0 + t * 64));
#endif
#ifndef DIS_A
    { const int Rp = (MP - F.sc_row0) < F.R ? (MP - F.sc_row0) : F.R; const int npc = Rp >> 7, nch = npc + ((F.R - Rp) >> 6);
#pragma unroll 1
    for (int rp = 0; rp < PROBE_MIX_A; ++rp)
#pragma unroll 1
    for (int t = (F.vcu + F.G - (1 * nrb) % F.G) % F.G; t < nch; t += F.G) { const bool pc = t < npc; mix_A(F, A, F.sc_row0 + (pc ? 128 * t : Rp + 64 * (t - npc)), pc ? 128 : 64); } }
#endif
#ifndef DIS_C
#pragma unroll 1
    for (int rp = 0; rp < PROBE_MIX_C; ++rp)
#pragma unroll 1
    for (int t = (F.vcu + F.G - (2 * nrb) % F.G) % F.G; t < nrb; t += F.G) mix_C(F, A, row_blk(F.sc_row0 + t * 64));
#endif
#ifndef DIS_D
#pragma unroll 1
    for (int rp = 0; rp < PROBE_MIX_D; ++rp)
#pragma unroll 1
    for (int t = (F.vcu + F.G - (3 * nrb) % F.G) % F.G; t < nrb; t += F.G) mix_D(F, A, row_blk(F.sc_row0 + t * 64));
#endif
}
template <int K> __device__ __forceinline__ f32x4 small_tile(const bf16* Arow, const bf16* Brow) {
    f32x4 acc = (f32x4){0.f, 0.f, 0.f, 0.f};
#pragma unroll 16
    for (int ks = 0; ks < K / 32; ++ks) { const bf16x8 a = *(const bf16x8*)(Arow + ks * 32), b = *(const bf16x8*)(Brow + ks * 32); acc = __builtin_amdgcn_mfma_f32_16x16x32_bf16(b, a, acc, 0, 0, 0); }
    return acc;
}
__device__ __forceinline__ void sample_branch(Frame& F, int Mp) {
    const int fr = F.lane & 15, fq = F.lane >> 4; const bf16* wb_t = (const bf16*)(F.ws + WS_WB);
#pragma unroll 1
    for (int tile = F.vcu; tile < 256; tile += F.G) {
        const int r0 = Mp + (tile >> 4) * 32 + (F.wave >> 2) * 16, c0 = (tile & 15) * 64 + (F.wave & 3) * 16; const size_t row = (size_t)(r0 + fr);
        f32x4 tot = (f32x4){0.f, 0.f, 0.f, 0.f};
#pragma unroll 1
        for (int X = 0; X < 4; ++X) {
            const f32x4 a = small_tile<512>(F.OUTS + (size_t)X * F.rtm * 256 * 512 + row * 512 + 8 * fq, wb_t + ((size_t)(F.l * 4 + X) * 1024 + c0 + fr) * 512 + 8 * fq);
            const int r_t = (int)(row & 255), c_t = (c0 + 4 * fq) & 255, cq = (c0 + 4 * fq) >> 8;
            const unsigned char* gp = F.G8 + (row >> 8) * 1048576 + (size_t)(4 * X + cq) * 65536
                + (((r_t >> 7) * 4 + ((r_t >> 4) & 3)) * 2 + (c_t >> 7)) * 4096 + ((((r_t >> 6) & 1) * 4 + ((c_t >> 5) & 3)) * 512) + ((r_t & 15) + 16 * ((c_t >> 3) & 3)) * 8 + (c_t & 7);
            const unsigned g = *(const unsigned*)gp;
            float r0 = (float)(g & 255u), r1 = (float)((g >> 8) & 255u), r2 = (float)((g >> 16) & 255u), r3 = (float)(g >> 24);
            if (X < 3) { const unsigned h = *(const unsigned*)(gp + 4 * 65536); r0 *= __builtin_amdgcn_rcpf((float)(h & 255u)); r1 *= __builtin_amdgcn_rcpf((float)((h >> 8) & 255u)); r2 *= __builtin_amdgcn_rcpf((float)((h >> 16) & 255u)); r3 *= __builtin_amdgcn_rcpf((float)(h >> 24)); }
            else { r0 *= (1.0f / 255.0f); r1 *= (1.0f / 255.0f); r2 *= (1.0f / 255.0f); r3 *= (1.0f / 255.0f); }
            tot[0] = (tot[0] + a[0]) * r0; tot[1] = (tot[1] + a[1]) * r1; tot[2] = (tot[2] + a[2]) * r2; tot[3] = (tot[3] + a[3]) * r3;
        }
        v2u o; o.x = pk2(tot[0], tot[1]); o.y = pk2(tot[2], tot[3]);
        *(v2u*)(F.H + row * 1024 + c0 + 4 * fq) = o;
    }
}
__device__ __forceinline__ void sample_out(Frame& F, int Mp) {
    const int fr = F.lane & 15, fq = F.lane >> 4; const bf16* wo_t = (const bf16*)(F.ws + WS_WO);
#pragma unroll 1
    for (int tile = F.vcu; tile < 256; tile += F.G) {
        const int r0 = Mp + (tile >> 4) * 32 + (F.wave >> 2) * 16, c0 = (tile & 15) * 64 + (F.wave & 3) * 16; const size_t row = (size_t)(r0 + fr);
        const f32x4 a = small_tile<1024>(F.H + row * 1024 + 8 * fq, wo_t + ((size_t)F.l * 1024 + c0 + fr) * 1024 + 8 * fq);
        v2u o; o.x = pk2(a[0], a[1]); o.y = pk2(a[2], a[3]);
        *(v2u*)(F.OUTS + row * 1024 + c0 + 4 * fq) = o;
    }
}
__device__ __forceinline__ void phase_E(Frame& F, ArgP A) {
    const int l = F.l, lane = F.lane; const int gw = F.vcu * NWAVES + F.wave, NGW = F.G * NWAVES;
    const bf16* Y = F.OUTS; float* xo = F.out + O_Y;
    const float* gpost = A->in[I_GPOST] + l * DM; const float* gnext = A->in[I_GPRE] + (l + 1 < DEPTH ? (l + 1) * DM : 0);
#pragma unroll 1
    for (int rr0 = gw; rr0 < F.R; rr0 += 2 * NGW) {
        v4u yraw[2][2]; f32x4 xv[2][4];
#pragma unroll
        for (int u = 0; u < 2; ++u) { const int rq = rr0 + u * NGW; const int r = rq < F.R ? rq : rr0; const int m = F.sc_row0 + r;
#pragma unroll
            for (int i = 0; i < 2; ++i) yraw[u][i] = *(const v4u*)(Y + (size_t)r * DM + 8 * lane + 512 * i);
            if (l == 0) { const float* xr = xin_row(F, A, m);
#pragma unroll
                for (int i = 0; i < 2; ++i) { xv[u][2 * i] = *(const f32x4*)(xr + 8 * lane + 512 * i); xv[u][2 * i + 1] = *(const f32x4*)(xr + 8 * lane + 512 * i + 4); } }
            else { const bf16* x16 = F.X1 + (size_t)r * DM;
#pragma unroll
                for (int i = 0; i < 2; ++i) { float t8[8]; unpack8(*(const v4u*)(x16 + 8 * lane + 512 * i), t8);
                    xv[u][2 * i] = (f32x4){t8[0], t8[1], t8[2], t8[3]}; xv[u][2 * i + 1] = (f32x4){t8[4], t8[5], t8[6], t8[7]}; } } }
#pragma unroll
        for (int u = 0; u < 2; ++u) { const int r = rr0 + u * NGW; if (r < F.R) { const int m = F.sc_row0 + r;
            float y[16]; float s = 0.f;
#pragma unroll
            for (int i = 0; i < 2; ++i) { float t8[8]; unpack8(yraw[u][i], t8);
#pragma unroll
                for (int k = 0; k < 8; ++k) { y[8 * i + k] = t8[k]; s += t8[k] * t8[k]; } }
            const float rr = rsqrtf(wave_sum(s) * (1.f / DM) + EPS); float s2 = 0.f;
#pragma unroll
            for (int i = 0; i < 4; ++i) { const f32x4 g = *(const f32x4*)(gpost + 8 * lane + 512 * (i >> 1) + 4 * (i & 1)); f32x4 xx = xv[u][i];
                xx.x += y[4 * i + 0] * rr * g.x; xx.y += y[4 * i + 1] * rr * g.y; xx.z += y[4 * i + 2] * rr * g.z; xx.w += y[4 * i + 3] * rr * g.w;
                s2 += (xx.x * xx.x + xx.y * xx.y) + (xx.z * xx.z + xx.w * xx.w); xv[u][i] = xx;
                if (l + 1 == DEPTH) *(f32x4*)(xo + (size_t)m * DM + 8 * lane + 512 * (i >> 1) + 4 * (i & 1)) = xx; }
            if (l + 1 < DEPTH) { const float r2 = rsqrtf(wave_sum(s2) * (1.f / DM) + EPS); bf16* x16 = F.X1 + (size_t)r * DM;
#pragma unroll
                for (int i = 0; i < 2; ++i) { const f32x4 g0 = *(const f32x4*)(gnext + 8 * lane + 512 * i), g1 = *(const f32x4*)(gnext + 8 * lane + 512 * i + 4);
                    const f32x4 xa = xv[u][2 * i], xb = xv[u][2 * i + 1];
                    v4u xs; xs.x = pk2(xa.x, xa.y); xs.y = pk2(xa.z, xa.w); xs.z = pk2(xb.x, xb.y); xs.w = pk2(xb.z, xb.w);
                    *(v4u*)(x16 + 8 * lane + 512 * i) = xs;
                    const f32x4 a = xa * r2 * g0, b = xb * r2 * g1; v4u o; o.x = pk2(a.x, a.y); o.y = pk2(a.z, a.w); o.z = pk2(b.x, b.y); o.w = pk2(b.z, b.w);
                    *(v4u*)(F.H + (size_t)r * DM + 8 * lane + 512 * i) = o; } }
        } }
    }
}

#define XB_TMO      128
#define XB_XCNT(j)  (256  + 64 * (j))
#define XB_XSUB(j)  (1280 + 64 * (j))
#define XB_XGEN(j)  (2304 + 64 * (j))
#define XB_TOP      3328
#define XB_TOPGEN   3392
#define XCD_BAR_WORDS 3456
#define XB_SPIN_CAP (1u << 18)

__device__ __forceinline__ unsigned xb_ld(unsigned* p)              { return __hip_atomic_load(p, __ATOMIC_RELAXED, __HIP_MEMORY_SCOPE_AGENT); }
__device__ __forceinline__ unsigned xb_add(unsigned* p, unsigned v) { return __hip_atomic_fetch_add(p, v, __ATOMIC_RELAXED, __HIP_MEMORY_SCOPE_AGENT); }
__device__ __forceinline__ unsigned xb_xcc_id() { return (unsigned)__builtin_amdgcn_s_getreg((3 << 11) | 20) & 0xFu; }
#define XB_SPIN(cond, bar) do { unsigned _sp = 0; while (cond) { __builtin_amdgcn_s_sleep(1); \
    if ((++_sp & 255u) == 0u) { if (xb_ld(&(bar)[XB_TMO])) break; if (_sp > XB_SPIN_CAP) { atomicAdd(&(bar)[XB_TMO], 1u); break; } } } } while (0)

struct XcdBarrier {
    unsigned* bar; unsigned x;
    volatile LAS unsigned* st;
};

__device__ __forceinline__ XcdBarrier xcd_barrier_post(unsigned* bar, volatile LAS unsigned* st) {
    XcdBarrier b; b.bar = bar; b.x = xb_xcc_id(); b.st = st;
    if (threadIdx.x == 0) (void)xb_add(&bar[XB_XCNT(b.x)], 1u);
    return b;
}
__device__ __forceinline__ void xcd_barrier_complete(unsigned* bar, unsigned x, unsigned& nloc, unsigned& nx) {
    const unsigned G = gridDim.x * gridDim.y * gridDim.z;
    unsigned sum, cnt, mine, sp = 0u;
    for (;;) {
        sum = 0u; cnt = 0u; mine = 0u;
#pragma unroll
        for (unsigned j = 0; j < 16; ++j) { const unsigned c = xb_ld(&bar[XB_XCNT(j)]); sum += c; cnt += (c > 0u) ? 1u : 0u; mine = (j == x) ? c : mine; }
        if (sum == G) break;
        __builtin_amdgcn_s_sleep(1);
        if ((++sp & 255u) == 0u) { if (xb_ld(&bar[XB_TMO])) break; if (sp > XB_SPIN_CAP) { atomicAdd(&bar[XB_TMO], 1u); break; } }
    }
    nloc = mine > 0u ? mine : 1u; nx = cnt > 0u ? cnt : 1u;
}

__device__ __forceinline__ void xcd_barrier(const XcdBarrier& b) {
    asm volatile("s_waitcnt vmcnt(0)" ::: "memory");
    __syncthreads();
    if (threadIdx.x == 0) {
        unsigned* bar = b.bar;
        __builtin_amdgcn_s_waitcnt(0);
        unsigned nloc = b.st[0], nx = b.st[1];
        if (nloc == 0u) { xcd_barrier_complete(bar, b.x, nloc, nx); b.st[0] = nloc; b.st[1] = nx; }
        const unsigned old = xb_add(&bar[XB_XSUB(b.x)], 1u);
        const unsigned gen = old / nloc;
        if (old + 1u == (gen + 1u) * nloc) {
            __builtin_amdgcn_fence(__ATOMIC_RELEASE, "agent");
            asm volatile("s_waitcnt vmcnt(0)" ::: "memory");
            const unsigned og = xb_add(&bar[XB_TOP], 1u);
            const unsigned tg = og / nx;
            if (og + 1u == (tg + 1u) * nx) xb_add(&bar[XB_TOPGEN], 1u);
            else XB_SPIN(xb_ld(&bar[XB_TOPGEN]) == tg, bar);
            __builtin_amdgcn_fence(__ATOMIC_ACQUIRE, "agent");
            xb_add(&bar[XB_XGEN(b.x)], 1u);
            asm volatile("s_waitcnt vmcnt(0)" ::: "memory");
        } else {
            XB_SPIN(xb_ld(&bar[XB_XGEN(b.x)]) == gen, bar);
            __builtin_amdgcn_fence(__ATOMIC_ACQUIRE, "agent");
            asm volatile("s_waitcnt vmcnt(0)" ::: "memory");
        }
    }
    __syncthreads();
}

constexpr int CW_BAR = 4096;
constexpr int LDS_BARST = LDS_BYTES - 64;
#ifndef PROBE_REP
#define PROBE_REP 0
#endif
#ifndef PROBE_BAR2
#define PROBE_BAR2 0
#endif
__global__ void __launch_bounds__(NWAVES * 64, 2) mega_fwd(Args args) {
    extern __shared__ __attribute__((aligned(16))) unsigned char lds[];
    cg::grid_group grid = cg::this_grid();
    Frame F;
    F.lds = (LAS unsigned char*)lds;
    if (threadIdx.x < 16) ((LAS unsigned*)(F.lds + LDS_BARST))[threadIdx.x] = 0u;
    __syncthreads();
    if (args.ph_hi - args.ph_lo > 1) (void)xcd_barrier_post((unsigned*)(args.ws + WS_CTL) + CW_BAR, (volatile LAS unsigned*)(F.lds + LDS_BARST));
    const int lo = args.ph_lo, hi = args.ph_hi;
    ArgP ap = (ArgP)__builtin_amdgcn_kernarg_segment_ptr();
#if PROBE_REP
    int rep_done = 0;
#endif
#pragma unroll 1
    for (int ph = lo; ph < hi; ++ph) {
        asm volatile("" : "+s"(ap));
        int tid_ = threadIdx.x, bx = blockIdx.x; asm volatile("" : "+v"(tid_)); asm volatile("" : "+s"(bx));
        F.tid = tid_; F.lane = F.tid & 63; F.wave = __builtin_amdgcn_readfirstlane(F.tid >> 6);
        F.G = gridDim.x; F.vcu = (F.G % 8 == 0) ? (bx % 8) * (F.G / 8) + bx / 8 : bx;
        const int nsc = ap->nsc, tps = NTP / nsc;
        F.out = ap->out; F.ws = ap->ws; F.rtm = tps + 2;
        F.H = (bf16*)(F.ws + WS_H); F.OUTS = F.H + (size_t)F.rtm * 256 * 1024; F.PROJ = F.OUTS + (size_t)F.rtm * 256 * 2048; F.X1 = F.PROJ + (size_t)F.rtm * 256 * PP;
        if (ph == 0) {
#ifndef DIS_P
            phase_prep(F, ap, tps * 256 + (nsc == 1 ? MS : 0));
#endif
        } else {
            const int q = ph - 1, s = q / 10, l = (q / 5) & 1, k = q % 5;
            F.sc_row0 = s * tps * 256; F.R = (tps + (s == nsc - 1 ? 2 : 0)) * 256; F.l = l;
            F.G8 = (unsigned char*)(F.out + O_Y) + (size_t)F.sc_row0 * 4096;
            if (k == 0) {
                pg8::Gemm g{F.H, (const bf16*)(F.ws + WS_WIN) + (size_t)l * NIN * DM, F.R, NIN, DM}; pg8::StaticOrder S; S.init(F.R, NIN, F.G, bx);
                pg8::EpiProj E{F.PROJ, ap->in[I_BGATE] + l * 4096, F.G8};
#ifndef DIS_G1
#if defined(PROBE_SAME) && PROBE_REP
                if (!rep_done) { pg8::SameOrder S2; S2.init(F.R, NIN, F.G, bx); pg8::gemm_phase<pg8::EpiProj, pg8::SameOrder, PG8_ALIGN, PG8_SP2>(F.lds, g, S2, E); } else
#endif
                pg8::gemm_phase<pg8::EpiProj, pg8::StaticOrder, PG8_ALIGN, PG8_SP2>(F.lds, g, S, E);
#endif
            } else if (k == 1) {
                phase_mix(F, ap);
            } else if (k == 2) {
                const int Mp = tps * 256;
                pg8::Gemm g{F.OUTS, (const bf16*)(F.ws + WS_WB) + (size_t)l * 4 * DM * WBR, Mp, DM, WBR}; pg8::BranchOrder S; S.init(Mp, F.G, bx, F.rtm); S.proj = F.PROJ; S.junk = F.lds + 131072; S.tid = F.tid;
                pg8::EpiBranch E{F.H, F.PROJ, F.rtm, F.G8};
#ifndef DIS_G2
                pg8::gemm_phase<pg8::EpiBranch, pg8::BranchOrder, PG8_ALIGN, PG8_SP2>(F.lds, g, S, E);
#endif
                if (F.R > Mp) sample_branch(F, Mp);
            } else if (k == 3) {
                const int Mp = tps * 256;
                pg8::Gemm g{F.H, (const bf16*)(F.ws + WS_WO) + (size_t)l * DM * DM, Mp, DM, DM}; pg8::StaticOrder S; S.init(Mp, DM, F.G, bx);
                pg8::EpiPlain E{F.OUTS, DM};
#ifndef DIS_G3
                pg8::gemm_phase<pg8::EpiPlain, pg8::StaticOrder, PG8_ALIGN, PG8_SP2>(F.lds, g, S, E);
#endif
                if (F.R > Mp) sample_out(F, Mp);
            } else {
#ifndef DIS_E
                phase_E(F, ap);
                if (l == DEPTH - 1 && s + 1 < nsc) { const int r0 = (s + 1) * tps * 256, nr = (tps + (s + 1 == nsc - 1 ? 2 : 0)) * 256; prenorm_rows(F, ap, r0, nr, F.H); }
#endif
            }
        }
        if (ph + 1 < hi) {
            if (ph == 0) grid.sync();
            else { XcdBarrier xb; xb.bar = (unsigned*)(ap->ws + WS_CTL) + CW_BAR; xb.x = xb_xcc_id(); xb.st = (volatile LAS unsigned*)(F.lds + LDS_BARST); xcd_barrier(xb);
#if PROBE_BAR2
                xcd_barrier(xb);
#endif
            }
        }
#if PROBE_REP
        { const int kk_ = (ph == 0) ? 5 : (ph - 1) % 5; const bool want = ((PROBE_REP >> kk_) & 1) && !(kk_ == 4 && (((ph - 1) / 5) & 1)) && ph > 0 && ph + 1 < hi;
          if (want && !rep_done) { rep_done = 1; --ph; } else rep_done = 0; }
#endif
    }
}


extern "C" void kernel_launch(void* const* d_in, const int* in_sizes, int n_in, void* d_out, int out_size, void* d_ws, size_t ws_size, hipStream_t stream) {
    static int grid = 0, nsc = 0;
    if (grid == 0) {
        if (n_in != 22 || in_sizes[0] != MP * DM || (size_t)out_size != O_END) { fprintf(stderr, "kernel_launch: unexpected shapes (n_in %d, in0 %d, out %d)\n", n_in, n_in > 0 ? in_sizes[0] : -1, out_size); grid = -1; return; }
        nsc = 0;
        for (int c = 1; c <= 16; c *= 2) if (ws_size >= ws_need(NTP / c + 2)) { nsc = c; break; }
        if (nsc == 1) nsc = 2;
        if (nsc == 0) { fprintf(stderr, "kernel_launch: workspace too small (%zu)\n", ws_size); grid = -1; return; }
        int dev = 0, cus = 0, per_cu = 0;
        if (hipGetDevice(&dev) != hipSuccess || hipDeviceGetAttribute(&cus, hipDeviceAttributeMultiprocessorCount, dev) != hipSuccess) { grid = -1; return; }
        if (hipFuncSetAttribute((const void*)mega_fwd, hipFuncAttributeMaxDynamicSharedMemorySize, LDS_BYTES) != hipSuccess) { fprintf(stderr, "kernel_launch: hipFuncSetAttribute failed\n"); grid = -1; return; }
        if (hipOccupancyMaxActiveBlocksPerMultiprocessor(&per_cu, (const void*)mega_fwd, NWAVES * 64, LDS_BYTES) != hipSuccess || per_cu < 1) { fprintf(stderr, "kernel_launch: occupancy query says %d\n", per_cu); }
        (void)hipGetLastError();
        grid = cus;
        fprintf(stderr, "kernel_launch: grid %d, nsc %d, ws %zu\n", grid, nsc, ws_size);
    }
    if (grid < 0) return;
    if (hipMemsetAsync((char*)d_ws + WS_CTL, 0, CTL_ZERO_BYTES, stream) != hipSuccess) { fprintf(stderr, "kernel_launch: memset failed\n"); return; }
    Args a{};
    for (int i = 0; i < 22; ++i) a.in[i] = (const float*)d_in[i];
    a.out = (float*)d_out; a.ws = (unsigned char*)d_ws; a.nsc = nsc; a.pad = 0;
    const int nph = 1 + nsc * DEPTH * 5;
#if MK_PER_PHASE
    for (int p = 0; p < nph; ++p) { a.ph_lo = p; a.ph_hi = p + 1; hipLaunchKernelGGL(mega_fwd, dim3(grid), dim3(NWAVES * 64), LDS_BYTES, stream, a); }
#else
    a.ph_lo = 0; a.ph_hi = nph;
    void* kargs[] = {&a};
    hipError_t e = hipLaunchCooperativeKernel((const void*)mega_fwd, dim3(grid), dim3(NWAVES * 64), kargs, LDS_BYTES, stream);
    if (e != hipSuccess) fprintf(stderr, "kernel_launch: cooperative launch failed: %s\n", hipGetErrorString(e));
#endif
}
```

```cpp
#include <hip/hip_runtime.h>
#include <hip/hip_cooperative_groups.h>
#include <cstdio>
#include <cstdint>
namespace cg = cooperative_groups;
#define CHB 4
namespace pg8 {
#define PG8_LAS __attribute__((address_space(3)))
typedef unsigned short bf16_t;
typedef short bf16x8 __attribute__((ext_vector_type(8)));
typedef float f32x4 __attribute__((ext_vector_type(4)));
typedef unsigned u32x4 __attribute__((ext_vector_type(4)));
constexpr int BM = 256, BK = 64, HALF = 128, HTB = HALF * BK * 2  , STAGE_BYTES = 8 * HTB, NXCD = 8, WGM = 8;

__host__ __device__ __forceinline__ int lds_byte(int r, int c) { const int st = (r >> 4) * 2 + (c >> 5), rr = r & 15, cc = c & 31, ob = rr * 64 + cc * 2; return st * 1024 + (ob ^ (((ob >> 9) & 1) << 5)); }
__host__ __device__ __forceinline__ void stage_rc(int b, int& R, int& C) { const int st = b / 1024, sb = b % 1024, swz = sb ^ (((sb >> 9) & 1) << 5); R = (st >> 1) * 16 + swz / 64; C = (st & 1) * 32 + (swz % 64) / 2; }
__host__ __device__ __forceinline__ int perm32(int rho) { const int n = rho >> 4, i = rho & 15; return 8 * (i >> 2) + 4 * n + (i & 3); }

struct Unit { int pm, pn; };
struct Gemm { const bf16_t* A; const bf16_t* Bt; int M, N, K; };

struct StaticOrder {
    int nM, nN, nwg, G, c;
    __host__ __device__ void init(int M, int N, int G_, int c_) { nM = M / BM; nN = N / BM; nwg = nM * nN; G = G_; c = c_; }
    __host__ __device__ bool next(int i, Unit& u) const {
        const long L = (long)i * G + c; if (L >= nwg) return false;
        int wgid = (int)L; { const int q = nwg / NXCD, r = nwg % NXCD, xcd = wgid % NXCD, off = wgid / NXCD; wgid = (xcd < r ? xcd * (q + 1) : r * (q + 1) + (xcd - r) * q) + off; }
        const int nig = WGM * nN, gid = wgid / nig, fm = gid * WGM, gsz = (nM - fm) < WGM ? (nM - fm) : WGM;
        u.pm = fm + ((wgid % nig) % gsz); u.pn = (wgid % nig) / gsz; return true;
    }
    __device__ __forceinline__ void a_ready(const Unit&) const {}
    __device__ __forceinline__ void done(const Unit&) const {}
};
__device__ __forceinline__ unsigned cvt_pk_bf16(float lo, float hi) { unsigned r; asm volatile("v_cvt_pk_bf16_f32 %0, %1, %2" : "=v"(r) : "v"(lo), "v"(hi)); return r; }
typedef float f32x2 __attribute__((ext_vector_type(2)));
__device__ __forceinline__ float fast_sigmoid(float x) { return __builtin_amdgcn_rcpf(1.0f + __expf(-x)); }
__device__ __forceinline__ float fast_silu(float x) { return x * __builtin_amdgcn_rcpf(1.0f + __expf(-x)); }
__device__ __forceinline__ float bflo(unsigned w) { return __uint_as_float(w << 16); }
__device__ __forceinline__ float bfhi(unsigned w) { return __uint_as_float(w & 0xffff0000u); }

struct EpiProj {
    static constexpr bool PERM = true, AFTER_DRAIN = false, PROBE2 = true, CHAIN = false;
    bf16_t* O; const float* bgate; unsigned char* g8;
    __device__ __forceinline__ void operator()(const f32x4 (&acc)[2][2][4][2], const Unit& u, int wr, int wc, int fr, int fq) const {
        const int row0 = u.pm * BM + wr * 64 + fr; const int pn = u.pn, colt = pn * BM; const int col0 = colt + wc * 32 + 8 * fq;
        const int kind = (pn >= 24) ? 4 : (pn < 4 ? 5 : ((pn >= 6 && pn < 10) ? 1 : ((pn >= 16 && pn < 20) ? 2 : ((pn >= 20) ? 3 : 0))));
        const int oshift = (pn == 4 || pn == 5) ? -512 : ((pn >= 10 && pn < 16) ? -1024 : 0); const bool zs = (pn == 10 || pn == 11 || pn == 14 || pn == 15);
        if (kind == 0) {
#pragma unroll
            for (int ai = 0; ai < 2; ++ai)
#pragma unroll
                for (int m = 0; m < 4; ++m) { bf16_t* rowp = O + (size_t)(row0 + ai * HALF + m * 16) * 4096 + col0 + oshift;
#pragma unroll
                    for (int bj = 0; bj < 2; ++bj) { f32x4 v0 = acc[ai][bj][m][0], v1 = acc[ai][bj][m][1];
                        if (zs) {
#pragma unroll
                            for (int j = 0; j < 4; ++j) { v0[j] = fast_silu(v0[j]); v1[j] = fast_silu(v1[j]); } }
                        u32x4 w; w.x = cvt_pk_bf16(v0[0], v0[1]); w.y = cvt_pk_bf16(v0[2], v0[3]); w.z = cvt_pk_bf16(v1[0], v1[1]); w.w = cvt_pk_bf16(v1[2], v1[3]);
                        *(u32x4*)(rowp + bj * HALF) = w; } }
        } else if (kind == 4) {
            f32x4 bv[2][2];
#pragma unroll
            for (int bj = 0; bj < 2; ++bj)
#pragma unroll
                for (int n = 0; n < 2; ++n) bv[bj][n] = *(const f32x4*)(bgate + (col0 - 6144) + bj * HALF + 4 * n);
            unsigned char* img = g8 + (size_t)u.pm * 1048576 + (size_t)(pn - 24) * 65536 + (wr * 4 + wc) * 512 + (fr + 16 * fq) * 8;
#pragma unroll
            for (int ai = 0; ai < 2; ++ai)
#pragma unroll
                for (int m = 0; m < 4; ++m)
#pragma unroll
                    for (int bj = 0; bj < 2; ++bj) { const f32x4 v0 = acc[ai][bj][m][0] + bv[bj][0], v1 = acc[ai][bj][m][1] + bv[bj][1];
                        unsigned lo = 0u, hi = 0u;
#pragma unroll
                        for (int j = 0; j < 4; ++j) { lo = __builtin_amdgcn_cvt_pk_u8_f32(fmaxf(255.0f * fast_sigmoid(v0[j]), 1.0f), j, lo); hi = __builtin_amdgcn_cvt_pk_u8_f32(fmaxf(255.0f * fast_sigmoid(v1[j]), 1.0f), j, hi); }
                        typedef unsigned u32x2 __attribute__((ext_vector_type(2)));
                        *(u32x2*)(img + ((ai * 4 + m) * 2 + bj) * 4096) = (u32x2){lo, hi}; }
        } else {
            const int ocol = (kind == 5 ? pn * 128 : (kind == 1 ? 1024 + (pn - 6) * 128 : (kind == 2 ? 3072 + (pn - 16) * 128 : 3584 + (pn - 20) * 128))) + wc * 32 + 8 * fq;
#pragma unroll
            for (int ai = 0; ai < 2; ++ai)
#pragma unroll
                for (int m = 0; m < 4; ++m) { f32x4 r0, r1; const f32x4 a0 = acc[ai][0][m][0], a1 = acc[ai][0][m][1], b0 = acc[ai][1][m][0], b1 = acc[ai][1][m][1];
#pragma unroll
                    for (int j = 0; j < 4; ++j) {
                        if (kind == 1) { r0[j] = a0[j] * fast_sigmoid(b0[j]); r1[j] = a1[j] * fast_sigmoid(b1[j]); }
                        else if (kind == 2 || kind == 5) { r0[j] = a0[j] * fast_silu(b0[j]); r1[j] = a1[j] * fast_silu(b1[j]); }
                        else { r0[j] = a0[j] * b0[j]; r1[j] = a1[j] * b1[j]; } }
                    u32x4 w; w.x = cvt_pk_bf16(r0[0], r0[1]); w.y = cvt_pk_bf16(r0[2], r0[3]); w.z = cvt_pk_bf16(r1[0], r1[1]); w.w = cvt_pk_bf16(r1[2], r1[3]);
                    *(u32x4*)(O + (size_t)(row0 + ai * HALF + m * 16) * 4096 + ocol) = w; }
        }
    }
};
struct EpiPlain {
    static constexpr bool PERM = true, AFTER_DRAIN = false, PROBE2 = false, CHAIN = false;
    bf16_t* O; int ldc;
    __device__ __forceinline__ void operator()(const f32x4 (&acc)[2][2][4][2], const Unit& u, int wr, int wc, int fr, int fq) const {
        const int row0 = u.pm * BM + wr * 64 + fr; const int col0 = u.pn * BM + wc * 32 + 8 * fq;
#pragma unroll
        for (int ai = 0; ai < 2; ++ai)
#pragma unroll
            for (int m = 0; m < 4; ++m) { bf16_t* rowp = O + (size_t)(row0 + ai * HALF + m * 16) * ldc + col0;
#pragma unroll
                for (int bj = 0; bj < 2; ++bj) { const f32x4 v0 = acc[ai][bj][m][0], v1 = acc[ai][bj][m][1];
                    u32x4 w; w.x = cvt_pk_bf16(v0[0], v0[1]); w.y = cvt_pk_bf16(v0[2], v0[3]); w.z = cvt_pk_bf16(v1[0], v1[1]); w.w = cvt_pk_bf16(v1[2], v1[3]);
                    *(u32x4*)(rowp + bj * HALF) = w; } }
    }
};
#ifndef CHB
#define CHB 2
#endif
struct EpiBranch {
    static constexpr bool PERM = true, AFTER_DRAIN = false, PROBE2 = false, CHAIN = true;
    bf16_t* Mg; const bf16_t* proj; int rtm; const unsigned char* g8;
    __device__ __forceinline__ bool last(const Unit& u) const { return (u.pn >> 2) == 3; }
    typedef unsigned u32x2 __attribute__((ext_vector_type(2)));
    __device__ __forceinline__ void scale4(f32x4& v, const unsigned g, const unsigned h, bool div) const {
#pragma unroll
        for (int k = 0; k < 4; ++k) { const float gq = (float)((g >> (8 * k)) & 255u), hq = (float)((h >> (8 * k)) & 255u);
            v[k] *= gq * (div ? __builtin_amdgcn_rcpf(hq) : (1.0f / 255.0f)); }
    }
    __device__ __forceinline__ void chain(f32x4 (&acc)[2][2][4][2], const Unit& u, int wr, int wc, int fr, int fq) const {
        const int X = u.pn >> 2, pn = u.pn & 3, pm = u.pm - X * rtm;
        const int row0 = pm * BM + wr * 64 + fr; const int col0 = pn * BM + wc * 32 + 8 * fq;
        const bool div = X < 3; const int hoff = div ? 4 * 65536 : 0;
        const unsigned char* img = g8 + (size_t)pm * 1048576 + (size_t)(4 * X + pn) * 65536 + (wr * 4 + wc) * 512 + (fr + 16 * fq) * 8;
#pragma unroll
        for (int ai = 0; ai < 2; ++ai)
#pragma unroll
            for (int m = 0; m < 4; m += CHB) {
                u32x2 g[CHB][2], h[CHB][2];
#pragma unroll
                for (int q = 0; q < CHB; ++q) { const unsigned char* gp = img + ((ai * 4 + m + q) * 2) * 4096;
                    g[q][0] = *(const u32x2*)gp; g[q][1] = *(const u32x2*)(gp + 4096); h[q][0] = *(const u32x2*)(gp + hoff); h[q][1] = *(const u32x2*)(gp + hoff + 4096); }
                __builtin_amdgcn_sched_barrier(0);
#pragma unroll
                for (int q = 0; q < CHB; ++q) { scale4(acc[ai][0][m + q][0], g[q][0].x, h[q][0].x, div); scale4(acc[ai][0][m + q][1], g[q][0].y, h[q][0].y, div);
                    scale4(acc[ai][1][m + q][0], g[q][1].x, h[q][1].x, div); scale4(acc[ai][1][m + q][1], g[q][1].y, h[q][1].y, div); }
                __builtin_amdgcn_sched_barrier(0);
            }
        if (X == 3) {
#pragma unroll
            for (int ai = 0; ai < 2; ++ai)
#pragma unroll
                for (int m = 0; m < 4; ++m) { bf16_t* mp = Mg + (size_t)(row0 + ai * HALF + m * 16) * 1024 + col0;
#pragma unroll
                    for (int bj = 0; bj < 2; ++bj) { const f32x4 v0 = acc[ai][bj][m][0], v1 = acc[ai][bj][m][1];
                        u32x4 w; w.x = cvt_pk_bf16(v0[0], v0[1]); w.y = cvt_pk_bf16(v0[2], v0[3]); w.z = cvt_pk_bf16(v1[0], v1[1]); w.w = cvt_pk_bf16(v1[2], v1[3]);
                        *(u32x4*)(mp + bj * HALF) = w; } }
        }
    }
};
struct BranchOrder {
    StaticOrder so; int rtm; const bf16_t* proj; PG8_LAS unsigned char* junk; int tid;
    __host__ __device__ void init(int M, int G_, int c_, int rtm_) { so.init(M, 1024, G_, c_); rtm = rtm_; }
    __host__ __device__ bool next(int i, Unit& u) const { Unit t; if (!so.next(i >> 2, t)) return false; const int X = i & 3; u.pm = t.pm + X * rtm; u.pn = t.pn + 4 * X; return true; }
    __device__ __forceinline__ void a_ready(const Unit&) const {}
    __device__ __forceinline__ void done(const Unit&) const {}
};
struct SameOrder : StaticOrder {
    __host__ __device__ bool next(int i, Unit& u) const { const bool r = StaticOrder::next(i, u); u.pm = 0; u.pn = 0; return r; }
};
template <class Epi, class Sched, bool ALIGN_EPI = false, bool SP2 = false>
__device__ __forceinline__ void gemm_phase(PG8_LAS unsigned char* lds, const Gemm g, const Sched& S, const Epi& E) {
    int tid_ = threadIdx.x; asm volatile("" : "+v"(tid_));
    const int tid = tid_, wid = __builtin_amdgcn_readfirstlane(tid >> 6), lane = tid & 63, wr = wid >> 2, wc = wid & 3, fr = lane & 15, fq = lane >> 4;
    const int K = g.K, nt = K / BK;
    unsigned voffA[2], voffB[2];
#pragma unroll
    for (int i = 0; i < 2; ++i) { int R, C; stage_rc(tid * 16 + i * 8192, R, C); const int Rb = Epi::PERM ? ((R & ~31) + perm32(R & 31)) : R;
        voffA[i] = (unsigned)(R * K + C) * 2u; voffB[i] = (unsigned)(Rb * K + C) * 2u; }
    const size_t kstep = (size_t)(BK * 2);
    const size_t hstep = (size_t)HALF * K * 2;
    const size_t tstep = 2 * hstep;
    const unsigned ldsw = (unsigned)wid * 1024u;
    const int aoff = lds_byte(wr * 64 + fr, fq * 8), boff = lds_byte(wc * 32 + fr, fq * 8);
#define PG8_SA(b, h) (((b) * 2 + (h)) * HTB)
#define PG8_SB(b, h) ((4 + (b) * 2 + (h)) * HTB)
#define PG8_STAGE(bufoff, gbase, voff) do { _Pragma("unroll") for (int _i = 0; _i < 2; ++_i) \
        __builtin_amdgcn_global_load_lds((const unsigned*)((const char*)(gbase) + (voff)[_i]), (PG8_LAS unsigned*)(lds + (bufoff) + ldsw + _i * 8192), 16, 0, 0); } while (0)
#define PG8_LDA(dst, b, h) do { _Pragma("unroll") for (int m = 0; m < 4; ++m) _Pragma("unroll") for (int k = 0; k < 2; ++k) dst[m][k] = *(const PG8_LAS bf16x8*)(lds + PG8_SA(b, h) + aoff + m * 2048 + k * 1024); } while (0)
#define PG8_LDB(dst, b, h) do { _Pragma("unroll") for (int n = 0; n < 2; ++n) _Pragma("unroll") for (int k = 0; k < 2; ++k) dst[n][k] = *(const PG8_LAS bf16x8*)(lds + PG8_SB(b, h) + boff + n * 2048 + k * 1024); } while (0)
#define PG8_MMA(ai, bj, At, Bt) do { __builtin_amdgcn_s_setprio(1); _Pragma("unroll") for (int m = 0; m < 4; ++m) _Pragma("unroll") for (int n = 0; n < 2; ++n) _Pragma("unroll") for (int k = 0; k < 2; ++k) \
        acc[ai][bj][m][n] = __builtin_amdgcn_mfma_f32_16x16x32_bf16(Bt[n][k], At[m][k], acc[ai][bj][m][n], 0, 0, 0); __builtin_amdgcn_s_setprio(0); } while (0)
#define PG8_WAIT_V(n) asm volatile("s_waitcnt vmcnt(" #n ")" ::: "memory")
#define PG8_WAIT_L(n) asm volatile("s_waitcnt lgkmcnt(" #n ")" ::: "memory")
#define PG8_BAR __builtin_amdgcn_s_barrier()
#define PG8_SCHED __builtin_amdgcn_sched_barrier(0)
    Unit cur, nxt; int ui = 0;
    if (!S.next(0, cur)) return;
    f32x4 acc[2][2][4][2];
#pragma unroll
    for (int a = 0; a < 2; ++a)
#pragma unroll
        for (int b = 0; b < 2; ++b)
#pragma unroll
            for (int m = 0; m < 4; ++m)
#pragma unroll
                for (int n = 0; n < 2; ++n) acc[a][b][m][n] = (f32x4){0.f, 0.f, 0.f, 0.f};
    bf16x8 At[4][2], B0[2][2], B1[2][2];
    const char* cA = (const char*)g.A + (size_t)cur.pm * tstep; const char* cB = (const char*)g.Bt + (size_t)cur.pn * tstep;
    S.a_ready(cur);
    if constexpr (SP2) {
        PG8_STAGE(PG8_SB(0, 0), cB, voffB); PG8_STAGE(PG8_SB(0, 1), cB + hstep, voffB); PG8_STAGE(PG8_SA(0, 0), cA, voffA); PG8_STAGE(PG8_SA(0, 1), cA + hstep, voffA);
        if (wr == 1) PG8_BAR;
        PG8_WAIT_V(2); PG8_BAR;
        PG8_STAGE(PG8_SB(1, 0), cB + kstep, voffB); PG8_STAGE(PG8_SA(1, 0), cA + kstep, voffA); PG8_STAGE(PG8_SB(1, 1), cB + hstep + kstep, voffB);
        PG8_WAIT_V(6); PG8_BAR;
    } else {
        PG8_STAGE(PG8_SB(0, 0), cB, voffB); PG8_STAGE(PG8_SA(0, 0), cA, voffA); PG8_STAGE(PG8_SB(0, 1), cB + hstep, voffB); PG8_STAGE(PG8_SA(0, 1), cA + hstep, voffA);
        if (wr == 1) PG8_BAR;
        PG8_WAIT_V(4); PG8_BAR;
        PG8_STAGE(PG8_SB(1, 0), cB + kstep, voffB); PG8_STAGE(PG8_SA(1, 0), cA + kstep, voffA); PG8_STAGE(PG8_SB(1, 1), cB + hstep + kstep, voffB);
        PG8_WAIT_V(6); PG8_BAR;
    }
    for (;;) {
        const bool has_next = S.next(ui + 1, nxt);
        const char* nA = has_next ? (const char*)g.A + (size_t)nxt.pm * tstep : cA; const char* nB = has_next ? (const char*)g.Bt + (size_t)nxt.pn * tstep : cB;
        for (int t = 0; t < nt; t += 2) {
            const bool last = (t == nt - 2);
            const char* a1 = cA + (size_t)(t + 1) * kstep;
            const char* a2 = last ? nA : cA + (size_t)(t + 2) * kstep; const char* b2 = last ? nB : cB + (size_t)(t + 2) * kstep;
            const char* a3 = a2 + kstep; const char* b3 = b2 + kstep;
            if (last && has_next) S.a_ready(nxt);
            if constexpr (SP2) {
            PG8_LDB(B0, 0, 0); PG8_LDB(B1, 0, 1); PG8_SCHED; PG8_LDA(At, 0, 0); PG8_STAGE(PG8_SA(1, 1), a1 + hstep, voffA);
            PG8_WAIT_V(8); PG8_WAIT_L(0); PG8_BAR; PG8_MMA(0, 0, At, B0); PG8_MMA(0, 1, At, B1); PG8_BAR; PG8_SCHED;
            PG8_LDA(At, 0, 1); PG8_STAGE(PG8_SB(0, 0), b2, voffB); PG8_STAGE(PG8_SB(0, 1), b2 + hstep, voffB); PG8_STAGE(PG8_SA(0, 0), a2, voffA);
            PG8_WAIT_V(8); PG8_WAIT_L(0); PG8_BAR; PG8_MMA(1, 0, At, B0); PG8_MMA(1, 1, At, B1); PG8_BAR; PG8_SCHED;
            PG8_LDB(B0, 1, 0); PG8_LDB(B1, 1, 1); PG8_SCHED; PG8_LDA(At, 1, 0); PG8_STAGE(PG8_SA(0, 1), a2 + hstep, voffA);
            PG8_WAIT_V(8); PG8_WAIT_L(0); PG8_BAR; PG8_MMA(0, 0, At, B0); PG8_MMA(0, 1, At, B1); PG8_BAR; PG8_SCHED;
            PG8_LDA(At, 1, 1); PG8_STAGE(PG8_SB(1, 0), b3, voffB); PG8_STAGE(PG8_SB(1, 1), b3 + hstep, voffB); PG8_STAGE(PG8_SA(1, 0), a3, voffA);
            PG8_WAIT_V(8); PG8_WAIT_L(0); PG8_BAR; PG8_MMA(1, 0, At, B0); PG8_MMA(1, 1, At, B1); PG8_BAR; PG8_SCHED;
            } else {
            PG8_LDB(B0, 0, 0); PG8_SCHED; PG8_LDA(At, 0, 0); PG8_STAGE(PG8_SA(1, 1), a1 + hstep, voffA);
            PG8_WAIT_L(8); PG8_BAR; PG8_WAIT_L(0); PG8_MMA(0, 0, At, B0); PG8_BAR; PG8_SCHED;
            PG8_LDB(B1, 0, 1); PG8_STAGE(PG8_SB(0, 0), b2, voffB);
            PG8_BAR; PG8_WAIT_L(0); PG8_MMA(0, 1, At, B1); PG8_BAR;
            PG8_LDA(At, 0, 1); PG8_STAGE(PG8_SA(0, 0), a2, voffA);
            PG8_BAR; PG8_WAIT_L(0); PG8_MMA(1, 0, At, B0); PG8_BAR; PG8_SCHED;
            PG8_STAGE(PG8_SB(0, 1), b2 + hstep, voffB);
            PG8_WAIT_V(6); PG8_BAR; PG8_MMA(1, 1, At, B1); PG8_BAR;
            PG8_LDB(B0, 1, 0); PG8_SCHED; PG8_LDA(At, 1, 0); PG8_STAGE(PG8_SA(0, 1), a2 + hstep, voffA);
            PG8_WAIT_L(8); PG8_BAR; PG8_WAIT_L(0); PG8_MMA(0, 0, At, B0); PG8_BAR; PG8_SCHED;
            PG8_LDB(B1, 1, 1); PG8_STAGE(PG8_SB(1, 0), b3, voffB);
            PG8_BAR; PG8_WAIT_L(0); PG8_MMA(0, 1, At, B1); PG8_BAR;
            PG8_LDA(At, 1, 1); PG8_STAGE(PG8_SA(1, 0), a3, voffA);
            PG8_BAR; PG8_WAIT_L(0); PG8_MMA(1, 0, At, B0); PG8_BAR; PG8_SCHED;
            PG8_STAGE(PG8_SB(1, 1), b3 + hstep, voffB);
            PG8_WAIT_V(6); PG8_BAR; PG8_MMA(1, 1, At, B1); PG8_BAR;
            }
        }
        if constexpr (ALIGN_EPI) { if (wr == 0) PG8_BAR; }
        if constexpr (Epi::CHAIN) { E.chain(acc, cur, wr, wc, fr, fq); S.done(cur); } else
        if constexpr (!Epi::AFTER_DRAIN) { E(acc, cur, wr, wc, fr, fq);
#if defined(PROBE_EPI2)
            if constexpr (Epi::PROBE2) { asm volatile("" ::: "memory"); E(acc, cur, wr, wc, fr, fq); }
#endif
            S.done(cur); }
        if (!has_next) break;
        bool zero_acc = true; if constexpr (Epi::CHAIN) zero_acc = E.last(cur);
        if (zero_acc)
#pragma unroll
        for (int a = 0; a < 2; ++a)
#pragma unroll
            for (int b = 0; b < 2; ++b)
#pragma unroll
                for (int m = 0; m < 4; ++m)
#pragma unroll
                    for (int n = 0; n < 2; ++n) acc[a][b][m][n] = (f32x4){0.f, 0.f, 0.f, 0.f};
        cur = nxt; cA = nA; cB = nB; ++ui;
        if constexpr (ALIGN_EPI) { if (wr == 1) PG8_BAR; }
    }
    PG8_WAIT_V(0);
    if constexpr (!ALIGN_EPI) { if (wr == 0) PG8_BAR; }
    PG8_BAR;
    if constexpr (Epi::AFTER_DRAIN) { E.fused(acc, cur, wr, wc, fr, fq, lds, wid, lane); S.done(cur); }
#undef PG8_SA
#undef PG8_SB
#undef PG8_STAGE
#undef PG8_LDA
#undef PG8_LDB
#undef PG8_MMA
#undef PG8_WAIT_V
#undef PG8_WAIT_L
#undef PG8_BAR
#undef PG8_SCHED
}
}
#ifndef PG8_SP2
#define PG8_SP2 true
#endif
#ifndef PG8_ALIGN
#define PG8_ALIGN true
#endif
#ifndef MK_PER_PHASE
#define MK_PER_PHASE 0
#endif

constexpr int DM = 1024, NIN = 10240, WBR = 512, DEPTH = 2;
constexpr int MP = 65536, MS = 512, MT = MP + MS;
constexpr int NTP = MP / 256;
constexpr float EPS = 1e-6f;
constexpr int PP = 4096, C_AU = 0, C_AV = 512, C_BA = 1024, C_BZ = 1536, C_CX = 2048, C_CZ = 2560, C_DB = 3072, C_DC = 3584;
constexpr size_t O_Y = 0, O_CONVP = (size_t)MT * DM, O_POOLP = O_CONVP + 2 * 16 * 30 * 512, O_SHORTP = O_POOLP + 2 * 16 * 15 * 512, O_CONVS = O_SHORTP + 2 * 16 * 2 * 512,
                 O_POOLS = O_CONVS + 2 * 8 * 30 * 512, O_SHORTS = O_POOLS + 2 * 8 * 15 * 512, O_VS = O_SHORTS + 2 * 8 * 2 * 512, O_END = O_VS + 2 * 8 * 64 * 512;
constexpr size_t MiB = 1u << 20;
constexpr size_t WS_CTL = 0, CTL_ZERO_BYTES = 1 * MiB;
constexpr size_t WS_WIN = 2 * MiB, WS_WB = 42 * MiB, WS_WO = 50 * MiB, WS_PW = 54 * MiB, WS_WSB = 54 * MiB + 512 * 1024, WS_H = 56 * MiB;
__host__ __device__ constexpr size_t ws_need(int rtm) { return WS_H + (size_t)rtm * 256 * (1024 + 2048 + 4096 + 1024) * 2; }

constexpr int LDS_BYTES = 163840;
constexpr int NWAVES = 8;

#define LAS __attribute__((address_space(3)))
typedef unsigned short bf16;
typedef unsigned v4u __attribute__((ext_vector_type(4)));
typedef unsigned v2u __attribute__((ext_vector_type(2)));
typedef float f32x4 __attribute__((ext_vector_type(4)));
typedef short bf16x8 __attribute__((ext_vector_type(8)));
#define LDS_WAIT() asm volatile("s_waitcnt lgkmcnt(0)" ::: "memory")
__device__ __forceinline__ unsigned f2bf(float f) { unsigned u = __builtin_bit_cast(unsigned, f); return (u + 0x7fffu + ((u >> 16) & 1u)) >> 16; }
__device__ __forceinline__ unsigned pk2(float lo, float hi) { unsigned r; asm("v_cvt_pk_bf16_f32 %0, %1, %2" : "=v"(r) : "v"(lo), "v"(hi)); return r; }
using pg8::bflo; using pg8::bfhi; using pg8::fast_sigmoid; using pg8::fast_silu;
__device__ __forceinline__ void unpack8(const v4u w, float (&v)[8]) { v[0] = bflo(w.x); v[1] = bfhi(w.x); v[2] = bflo(w.y); v[3] = bfhi(w.y); v[4] = bflo(w.z); v[5] = bfhi(w.z); v[6] = bflo(w.w); v[7] = bfhi(w.w); }
__device__ __forceinline__ v4u pack8(const float (&v)[8]) { v4u w; w.x = pk2(v[0], v[1]); w.y = pk2(v[2], v[3]); w.z = pk2(v[4], v[5]); w.w = pk2(v[6], v[7]); return w; }
__device__ __forceinline__ float dpp_add(float v, int) { return v; }
template <int CTRL> __device__ __forceinline__ float dpp_mov(float v) { return __builtin_bit_cast(float, __builtin_amdgcn_update_dpp(0, __builtin_bit_cast(int, v), CTRL, 0xf, 0xf, true)); }
__device__ __forceinline__ float wave_sum(float v) {
    v += dpp_mov<0xB1>(v);
    v += dpp_mov<0x4E>(v);
    v += dpp_mov<0x141>(v);
    v += dpp_mov<0x140>(v);
    const int iv = __builtin_bit_cast(int, v);
    const float r0 = __builtin_bit_cast(float, __builtin_amdgcn_readlane(iv, 0)), r1 = __builtin_bit_cast(float, __builtin_amdgcn_readlane(iv, 16)),
                r2 = __builtin_bit_cast(float, __builtin_amdgcn_readlane(iv, 32)), r3 = __builtin_bit_cast(float, __builtin_amdgcn_readlane(iv, 48));
    return (r0 + r1) + (r2 + r3);
}
typedef short v4i16_t __attribute__((ext_vector_type(4)));

struct Args { const float* in[22]; float* out; unsigned char* ws; int ph_lo, ph_hi, nsc, pad; };
typedef const __attribute__((address_space(4))) Args* ArgP;
struct Frame {
    LAS unsigned char* lds;
    int tid, lane, wave, vcu, G;
    float* out; unsigned char* ws;
    int l, sc_row0, R, rtm;
    bf16 *H, *OUTS, *PROJ, *X1;
    unsigned char* G8;
};
enum { I_XP = 0, I_XS, I_SCONV, I_SPOOL, I_SSHORT, I_GPRE, I_GPOST, I_WIN, I_BGATE, I_LNVG, I_LNVB, I_WS, I_BS, I_CONVW, I_CONVB, I_LNBG, I_LNBB, I_POOLW, I_PSCALE, I_CONVDW, I_WBR, I_WOUT };

__device__ __forceinline__ int gate_dst(int c) { if (c >= 6144) return c; const int part = c >> 9, k = (c >> 7) & 3, j = c & 127;
    switch (part) { case 0: return 256 * k + j; case 2: return 256 * k + 128 + j; case 1: return 1024 + (c & 511); case 3: return 1536 + 256 * k + j; case 4: return 1536 + 256 * k + 128 + j; case 8: return 4096 + 256 * k + j; case 11: return 4096 + 256 * k + 128 + j;
                    case 9: return 5120 + 256 * k + j; case 10: return 5120 + 256 * k + 128 + j; default: return c; } }
template <bool GATEPERM = false>
__device__ __forceinline__ void transpose_item(const float* W, int K, int N, bf16* WT, LAS float* scr, int item, int lane, const float* rowscale = nullptr) {
    const int nblk = N / 32, kb = item / nblk, nb = item % nblk, k0 = 64 * kb, n0 = 32 * nb;
#pragma unroll 8
    for (int i = 0; i < 32; ++i) { const int kk = 2 * i + (lane >> 5); scr[kk * 33 + (lane & 31)] = W[(size_t)(k0 + kk) * N + n0 + (lane & 31)]; }
    LDS_WAIT(); asm volatile("" ::: "memory");
    const int c = lane & 7;
#pragma unroll
    for (int j = 0; j < 4; ++j) { const int n = (lane >> 3) + 8 * j; const LAS float* s = scr + (8 * c) * 33 + n;
        const float rs = rowscale ? rowscale[n0 + n] : 1.0f;
        v4u o; o.x = pk2(s[0 * 33] * rs, s[1 * 33] * rs); o.y = pk2(s[2 * 33] * rs, s[3 * 33] * rs); o.z = pk2(s[4 * 33] * rs, s[5 * 33] * rs); o.w = pk2(s[6 * 33] * rs, s[7 * 33] * rs);
        const int drow = GATEPERM ? gate_dst(n0 + n) : (n0 + n);
        *(v4u*)(WT + (size_t)drow * K + k0 + 8 * c) = o; }
    LDS_WAIT(); asm volatile("" ::: "memory");
}
__device__ __forceinline__ const float* xin_row(const Frame& F, ArgP A, int m) { return m < MP ? A->in[I_XP] + (size_t)m * DM : A->in[I_XS] + (size_t)(m - MP) * DM; }
__device__ __forceinline__ void prenorm_row(const Frame& F, ArgP A, const float* xrow, const float* g, bf16* hrow) {
    f32x4 v[4]; float s = 0.f;
#pragma unroll
    for (int i = 0; i < 2; ++i) { v[2 * i] = *(const f32x4*)(xrow + 8 * F.lane + 512 * i); v[2 * i + 1] = *(const f32x4*)(xrow + 8 * F.lane + 512 * i + 4); }
#pragma unroll
    for (int i = 0; i < 4; ++i) s += (v[i].x * v[i].x + v[i].y * v[i].y) + (v[i].z * v[i].z + v[i].w * v[i].w);
    const float r = rsqrtf(wave_sum(s) * (1.f / DM) + EPS);
#pragma unroll
    for (int i = 0; i < 2; ++i) { const f32x4 g0 = *(const f32x4*)(g + 8 * F.lane + 512 * i), g1 = *(const f32x4*)(g + 8 * F.lane + 512 * i + 4);
        const f32x4 a = v[2 * i] * r * g0, b = v[2 * i + 1] * r * g1; v4u o; o.x = pk2(a.x, a.y); o.y = pk2(a.z, a.w); o.z = pk2(b.x, b.y); o.w = pk2(b.z, b.w);
        *(v4u*)(hrow + 8 * F.lane + 512 * i) = o; }
}
__device__ __forceinline__ void prenorm_rows(Frame& F, ArgP A, int row0, int nrows, bf16* H) {
    const int gw = F.vcu * NWAVES + F.wave, NGW = F.G * NWAVES;
#pragma unroll 1
    for (int r0 = gw; r0 < nrows; r0 += 2 * NGW) {
        f32x4 v[2][4];
#pragma unroll
        for (int u = 0; u < 2; ++u) { const int rq = r0 + u * NGW; const float* xrow = xin_row(F, A, row0 + (rq < nrows ? rq : r0));
#pragma unroll
            for (int i = 0; i < 2; ++i) { v[u][2 * i] = *(const f32x4*)(xrow + 8 * F.lane + 512 * i); v[u][2 * i + 1] = *(const f32x4*)(xrow + 8 * F.lane + 512 * i + 4); } }
#pragma unroll
        for (int u = 0; u < 2; ++u) { const int r = r0 + u * NGW; if (r < nrows) { float s = 0.f;
#pragma unroll
            for (int i = 0; i < 4; ++i) s += (v[u][i].x * v[u][i].x + v[u][i].y * v[u][i].y) + (v[u][i].z * v[u][i].z + v[u][i].w * v[u][i].w);
            const float rr = rsqrtf(wave_sum(s) * (1.f / DM) + EPS); const float* g = A->in[I_GPRE]; bf16* hrow = H + (size_t)r * DM;
#pragma unroll
            for (int i = 0; i < 2; ++i) { const f32x4 g0 = *(const f32x4*)(g + 8 * F.lane + 512 * i), g1 = *(const f32x4*)(g + 8 * F.lane + 512 * i + 4);
                const f32x4 a = v[u][2 * i] * rr * g0, b = v[u][2 * i + 1] * rr * g1; v4u o; o.x = pk2(a.x, a.y); o.y = pk2(a.z, a.w); o.z = pk2(b.x, b.y); o.w = pk2(b.z, b.w);
                *(v4u*)(hrow + 8 * F.lane + 512 * i) = o; } } }
    }
}
__device__ __forceinline__ void phase_prep(Frame& F, ArgP A, int sc0_rows) {
    LAS float* scr = (LAS float*)(F.lds + F.wave * 16384);
    const int gw = F.vcu * NWAVES + F.wave, NGW = F.G * NWAVES;
    bf16* win_t = (bf16*)(F.ws + WS_WIN); bf16* wb_t = (bf16*)(F.ws + WS_WB); bf16* wo_t = (bf16*)(F.ws + WS_WO); bf16* pw_t = (bf16*)(F.ws + WS_PW); bf16* ws_b = (bf16*)(F.ws + WS_WSB);
    constexpr int I_IN = (DM / 64) * (NIN / 32), I_BR = (WBR / 64) * (DM / 32), I_OUT = (DM / 64) * (DM / 32), I_PW = (128 / 64) * (128 / 32);
    constexpr int NITEMS = 2 * I_IN + 8 * I_BR + 2 * I_OUT + 8 * I_PW;
    for (int it = gw; it < NITEMS; it += NGW) {
        int r = it;
        if (r < 2 * I_IN) { const int l = r / I_IN; transpose_item<true>(A->in[I_WIN] + (size_t)l * DM * NIN, DM, NIN, win_t + (size_t)l * NIN * DM, scr, r % I_IN, F.lane); continue; } r -= 2 * I_IN;
        if (r < 8 * I_BR) { const int q = r / I_BR; transpose_item(A->in[I_WBR] + (size_t)q * WBR * DM, WBR, DM, wb_t + (size_t)q * DM * WBR, scr, r % I_BR, F.lane); continue; } r -= 8 * I_BR;
        if (r < 2 * I_OUT) { const int l = r / I_OUT; transpose_item(A->in[I_WOUT] + (size_t)l * DM * DM, DM, DM, wo_t + (size_t)l * DM * DM, scr, r % I_OUT, F.lane); continue; } r -= 2 * I_OUT;
        { const int q = r / I_PW; transpose_item(A->in[I_POOLW] + (size_t)q * 128 * 128, 128, 128, pw_t + (size_t)q * 128 * 128, scr, r % I_PW, F.lane, A->in[I_PSCALE] + (size_t)q * 128); }
    }
    for (int i = (F.vcu * NWAVES * 64 + F.tid); i < 2 * 4 * 128 * 128; i += F.G * NWAVES * 64) { const int s = i & 127, t = (i >> 7) & 127; ws_b[i] = (bf16)(s <= t ? f2bf(A->in[I_WS][i]) : 0u); }
    prenorm_rows(F, A, 0, sc0_rows, (bf16*)(F.ws + WS_H));
}

struct RowBlk { int m0, b, t0; bool smp, first, last; };
__device__ __forceinline__ RowBlk row_blk(int m0) { RowBlk r; r.m0 = m0; r.smp = m0 >= MP; r.b = r.smp ? (m0 - MP) >> 6 : m0 >> 12; r.t0 = r.smp ? 0 : (m0 & 4095); r.first = r.t0 == 0; r.last = r.smp ? true : (r.t0 == 4096 - 64); return r; }

__device__ __forceinline__ void mix_A(Frame& F, ArgP A, const int mc, const int ns) {
    const int l = F.l, lane = F.lane, fr = lane & 15, fq = lane >> 4;
    const bool smp = mc >= MP; const int sb_ = smp ? (mc - MP) >> 6 : 0;
    const bf16* Pc = F.PROJ + (size_t)(mc - F.sc_row0) * PP;
    LAS bf16* vN = (LAS bf16*)F.lds;
    {
        float g8[8], b8[8];
#pragma unroll
        for (int i = 0; i < 8; ++i) { g8[i] = A->in[I_LNVG][l * 512 + 8 * lane + i]; b8[i] = A->in[I_LNVB][l * 512 + 8 * lane + i]; }
#pragma unroll 1
        for (int sb = 0; sb < ns; sb += 64) {
            v4u raw[8];
#pragma unroll
            for (int j = 0; j < 8; ++j) raw[j] = *(const v4u*)(Pc + (size_t)(sb + F.wave + 8 * j) * PP + C_AV + 8 * lane);
#pragma unroll
            for (int j = 0; j < 8; ++j) { const int s = sb + F.wave + 8 * j;
                float v[8]; unpack8(raw[j], v);
                float sum = 0.f;
#pragma unroll
                for (int i = 0; i < 8; ++i) sum += v[i];
                const float mean = wave_sum(sum) * (1.f / 512.f); float q = 0.f;
#pragma unroll
                for (int i = 0; i < 8; ++i) { v[i] -= mean; q += v[i] * v[i]; }
                const float rstd = rsqrtf(wave_sum(q) * (1.f / 512.f) + EPS);
#pragma unroll
                for (int i = 0; i < 8; ++i) v[i] = v[i] * rstd * g8[i] + b8[i];
                if (smp) { float* o = F.out + O_VS + ((size_t)(l * 8 + sb_) * 64 + s) * 512 + 8 * lane; *(f32x4*)o = (f32x4){v[0], v[1], v[2], v[3]}; *(f32x4*)(o + 4) = (f32x4){v[4], v[5], v[6], v[7]}; }
                *(LAS v4u*)(vN + s * 528 + 8 * lane) = pack8(v);
            }
        }
    }
    __syncthreads();
    const int head = F.wave >> 1, cb0 = F.wave * 4;
#pragma unroll 1
    for (int half = 0; half < (ns >> 6); ++half) {
    const int m0 = mc + 64 * half;
    const bf16* W = (const bf16*)(F.ws + WS_WSB) + ((size_t)(l * 4 + head) * 128 + 64 * half) * 128;
    f32x4 acc[4][4];
#pragma unroll
    for (int a = 0; a < 4; ++a)
#pragma unroll
        for (int b = 0; b < 4; ++b) acc[a][b] = (f32x4){0.f, 0.f, 0.f, 0.f};
    const int nks = 2 + 2 * half;
    for (int ks = 0; ks < nks; ++ks) {
        bf16x8 xf[4], yf[4];
#pragma unroll
        for (int cb = 0; cb < 4; ++cb) { const LAS bf16* bp = vN + (ks * 32 + 8 * fq + (fr >> 2)) * 528 + (cb0 + cb) * 16 + 4 * (fr & 3);
            const v4i16_t lo = __builtin_amdgcn_ds_read_tr16_b64_v4i16((LAS v4i16_t*)bp), hi = __builtin_amdgcn_ds_read_tr16_b64_v4i16((LAS v4i16_t*)(bp + 4 * 528));
            xf[cb] = (bf16x8){lo.x, lo.y, lo.z, lo.w, hi.x, hi.y, hi.z, hi.w}; }
#pragma unroll
        for (int tb = 0; tb < 4; ++tb) yf[tb] = *(const bf16x8*)(W + (size_t)(tb * 16 + fr) * 128 + ks * 32 + fq * 8);
#pragma unroll
        for (int cb = 0; cb < 4; ++cb)
#pragma unroll
            for (int tb = 0; tb < 4; ++tb) acc[cb][tb] = __builtin_amdgcn_mfma_f32_16x16x32_bf16(xf[cb], yf[tb], acc[cb][tb], 0, 0, 0);
    }
    bf16* Oa = F.OUTS;
    {
        v2u uu[4][4]; float bsv[4];
#pragma unroll
        for (int tb = 0; tb < 4; ++tb) { const int t = tb * 16 + fr; const size_t row = (size_t)(m0 + t - F.sc_row0);
            bsv[tb] = A->in[I_BS][(l * 4 + head) * 128 + 64 * half + t];
#pragma unroll
            for (int cb = 0; cb < 4; ++cb) { const int c = (cb0 + cb) * 16 + 4 * fq; uu[tb][cb] = *(const v2u*)(F.PROJ + row * PP + C_AU + c); } }
#pragma unroll
        for (int tb = 0; tb < 4; ++tb)
#pragma unroll
            for (int cb = 0; cb < 4; ++cb) asm volatile("" : "+v"(uu[tb][cb]));
#pragma unroll
        for (int tb = 0; tb < 4; ++tb) { const int t = tb * 16 + fr; const size_t row = (size_t)(m0 + t - F.sc_row0); const float bs = bsv[tb];
#pragma unroll
            for (int cb = 0; cb < 4; ++cb) { const int c = (cb0 + cb) * 16 + 4 * fq; const v2u u = uu[tb][cb]; const f32x4 a = acc[cb][tb];
                v2u o; o.x = pk2(bflo(u.x) * (a[0] + bs), bfhi(u.x) * (a[1] + bs));
                o.y = pk2(bflo(u.y) * (a[2] + bs), bfhi(u.y) * (a[3] + bs));
                *(v2u*)(Oa + row * 512 + c) = o; } }
    }
    }
    __syncthreads();
}

__device__ __forceinline__ void mix_B(Frame& F, ArgP A, const RowBlk rb) {
    const int l = F.l, lane = F.lane;
    LAS bf16* G = (LAS bf16*)F.lds;
    const int nb = rb.smp ? 8 : 16;
#pragma unroll
    for (int jb = 0; jb < 12; jb += 6) {
        v4u ra[6];
#pragma unroll
        for (int j = 0; j < 6; ++j) { const int r = F.wave + 8 * (jb + j); int tl = r - 30; tl = tl > 63 ? 63 : tl; if (rb.first && tl < 0) tl = 0;
            const bf16* pr = F.PROJ + (size_t)(rb.m0 + tl - F.sc_row0) * PP; ra[j] = *(const v4u*)(pr + C_BA + 8 * lane); }
#pragma unroll
        for (int j = 0; j < 6; ++j) { const int r = F.wave + 8 * (jb + j); const int tl = r - 30;
            if (r < 94) {
                float glu[8];
                if (tl < 0 && rb.first) {
                    if (rb.smp) { const float* sp = A->in[I_SCONV] + ((size_t)(l * 8 + rb.b) * 30 + r) * 512 + 8 * lane; const f32x4 a = *(const f32x4*)sp, b = *(const f32x4*)(sp + 4);
                        glu[0] = a.x; glu[1] = a.y; glu[2] = a.z; glu[3] = a.w; glu[4] = b.x; glu[5] = b.y; glu[6] = b.z; glu[7] = b.w; }
                    else {
#pragma unroll
                        for (int i = 0; i < 8; ++i) glu[i] = 0.f; }
                } else {
                    unpack8(ra[j], glu);
                }
                *(LAS v4u*)(G + r * 512 + 8 * lane) = pack8(glu);
                if (rb.last && tl >= 34) { float* o = F.out + (rb.smp ? O_CONVS : O_CONVP) + ((size_t)(l * nb + rb.b) * 30 + (tl - 34)) * 512 + 8 * lane;
                    *(f32x4*)o = (f32x4){glu[0], glu[1], glu[2], glu[3]}; *(f32x4*)(o + 4) = (f32x4){glu[4], glu[5], glu[6], glu[7]}; }
            }
        }
    }
    __syncthreads();
    const int c = F.tid;
    LAS float* CBp = (LAS float*)(F.lds + 96256);
    float w[31];
#pragma unroll
    for (int k = 0; k < 31; ++k) w[k] = A->in[I_CONVW][(l * 31 + k) * 512 + c];
    const float bias = A->in[I_CONVB][l * 512 + c];
    const f32x4 g0 = *(const f32x4*)(A->in[I_LNBG] + l * 512 + 4 * lane), g1 = *(const f32x4*)(A->in[I_LNBG] + l * 512 + 256 + 4 * lane);
    const f32x4 b0 = *(const f32x4*)(A->in[I_LNBB] + l * 512 + 4 * lane), b1 = *(const f32x4*)(A->in[I_LNBB] + l * 512 + 256 + 4 * lane);
    bf16* Ob = F.OUTS + (size_t)F.rtm * 256 * 512;
#pragma unroll 1
    for (int rg = 0; rg < 2; ++rg) {
        v2u zq[4][2];
#pragma unroll
        for (int i = 0; i < 4; ++i) { const size_t row = (size_t)(rb.m0 + rg * 32 + F.wave * 4 + i - F.sc_row0); zq[i][0] = *(const v2u*)(F.PROJ + row * PP + C_BZ + 4 * lane); zq[i][1] = *(const v2u*)(F.PROJ + row * PP + C_BZ + 256 + 4 * lane); }
        {
            float x[62];
#pragma unroll
            for (int j = 0; j < 62; ++j) x[j] = __uint_as_float((unsigned)G[(rg * 32 + j) * 512 + c] << 16);
#pragma unroll
            for (int i = 0; i < 32; ++i) { float s = bias;
#pragma unroll
                for (int k = 0; k < 31; ++k) s += x[i + k] * w[k];
                CBp[i * 512 + c] = s; }
        }
        __syncthreads();
#pragma unroll
        for (int i = 0; i < 4; ++i) { const int ti = F.wave * 4 + i, t = rg * 32 + ti; const size_t row = (size_t)(rb.m0 + t - F.sc_row0);
            f32x4 v0 = *(const LAS f32x4*)(CBp + ti * 512 + 4 * lane), v1 = *(const LAS f32x4*)(CBp + ti * 512 + 256 + 4 * lane);
            const float mean = wave_sum((v0.x + v0.y) + (v0.z + v0.w) + (v1.x + v1.y) + (v1.z + v1.w)) * (1.f / 512.f);
            v0 = v0 - mean; v1 = v1 - mean;
            const float rstd = rsqrtf(wave_sum((v0.x * v0.x + v0.y * v0.y) + (v0.z * v0.z + v0.w * v0.w) + (v1.x * v1.x + v1.y * v1.y) + (v1.z * v1.z + v1.w * v1.w)) * (1.f / 512.f) + EPS);
            v0 = v0 * rstd * g0 + b0; v1 = v1 * rstd * g1 + b1;
            const v2u z0 = zq[i][0], z1 = zq[i][1];
            v2u q0, q1;
            q0.x = pk2(fast_silu(v0.x) * bflo(z0.x), fast_silu(v0.y) * bfhi(z0.x)); q0.y = pk2(fast_silu(v0.z) * bflo(z0.y), fast_silu(v0.w) * bfhi(z0.y));
            q1.x = pk2(fast_silu(v1.x) * bflo(z1.x), fast_silu(v1.y) * bfhi(z1.x)); q1.y = pk2(fast_silu(v1.z) * bflo(z1.y), fast_silu(v1.w) * bfhi(z1.y));
            *(v2u*)(Ob + row * 512 + 4 * lane) = q0; *(v2u*)(Ob + row * 512 + 256 + 4 * lane) = q1; }
        __syncthreads();
    }
}

__device__ __forceinline__ void mix_C(Frame& F, ArgP A, const RowBlk rb) {
    const int l = F.l, lane = F.lane, fr = lane & 15, fq = lane >> 4;
    LAS bf16* Pp = (LAS bf16*)F.lds;
    LAS bf16* Xs = (LAS bf16*)(F.lds + 69632);
    const int nb = rb.smp ? 8 : 16;
#pragma unroll
    for (int jb = 0; jb < 10; jb += 5) {
        v4u rv[5];
#pragma unroll
        for (int j = 0; j < 5; ++j) { const int r = F.wave + 8 * (jb + j); int tl = r - 15; tl = tl > 63 ? 63 : tl; if (rb.first && tl < 0) tl = 0;
            rv[j] = *(const v4u*)(F.PROJ + (size_t)(rb.m0 + tl - F.sc_row0) * PP + C_CX + 8 * lane); }
#pragma unroll
        for (int j = 0; j < 5; ++j) { const int r = F.wave + 8 * (jb + j); if (r < 79) *(LAS v4u*)(Xs + r * 512 + 8 * lane) = rv[j]; }
    }
    __syncthreads();
    {
        const int c = F.tid, g = F.wave >> 1;
        float h[15];
#pragma unroll
        for (int j = 0; j < 15; ++j) {
            float x = 0.f;
            if (rb.first) { if (rb.smp) x = A->in[I_SPOOL][((size_t)(l * 8 + rb.b) * 15 + (14 - j)) * 512 + c]; }
            else x = __uint_as_float((unsigned)Xs[(14 - j) * 512 + c] << 16);
            h[j] = x;
        }
        const float wf = (float)(2 << g); const int pos0 = (rb.smp ? 2048 : 0) + rb.t0;
#pragma unroll
        for (int t = 0; t < 64; ++t) {
            const float x = __uint_as_float((unsigned)Xs[(15 + t) * 512 + c] << 16);
            const float s2 = x + h[0], s4 = s2 + h[1] + h[2], s8 = s4 + (h[3] + h[4]) + (h[5] + h[6]), s16 = s8 + ((h[7] + h[8]) + (h[9] + h[10])) + ((h[11] + h[12]) + (h[13] + h[14]));
            const float sum = g == 0 ? s2 : (g == 1 ? s4 : (g == 2 ? s8 : s16));
            const float icnt = __builtin_amdgcn_rcpf(fminf((float)(pos0 + t + 1), wf));
            Pp[t * 520 + c] = (bf16)f2bf(sum * icnt - x);
            if (rb.last && t >= 49) F.out[(rb.smp ? O_POOLS : O_POOLP) + ((size_t)(l * nb + rb.b) * 15 + (t - 49)) * 512 + c] = x;
#pragma unroll
            for (int j = 14; j > 0; --j) h[j] = h[j - 1];
            h[0] = x;
        }
    }
    __syncthreads();
    const int g = F.wave >> 1, db0 = (F.wave & 1) * 4;
    const bf16* X = (const bf16*)(F.ws + WS_PW) + (size_t)(l * 4 + g) * 128 * 128;
    f32x4 acc[4][4];
#pragma unroll
    for (int a = 0; a < 4; ++a)
#pragma unroll
        for (int b = 0; b < 4; ++b) acc[a][b] = (f32x4){0.f, 0.f, 0.f, 0.f};
#pragma unroll
    for (int ks = 0; ks < 4; ++ks) {
        bf16x8 xf[4], yf[4];
#pragma unroll
        for (int db = 0; db < 4; ++db) xf[db] = *(const bf16x8*)(X + (size_t)((db0 + db) * 16 + fr) * 128 + ks * 32 + fq * 8);
#pragma unroll
        for (int tb = 0; tb < 4; ++tb) yf[tb] = *(const LAS bf16x8*)(Pp + (tb * 16 + fr) * 520 + g * 128 + ks * 32 + fq * 8);
#pragma unroll
        for (int db = 0; db < 4; ++db)
#pragma unroll
            for (int tb = 0; tb < 4; ++tb) acc[db][tb] = __builtin_amdgcn_mfma_f32_16x16x32_bf16(xf[db], yf[tb], acc[db][tb], 0, 0, 0);
    }
    bf16* Oc = F.OUTS + (size_t)2 * F.rtm * 256 * 512;
    LAS bf16* Zs = Xs;
    v4u zr[8];
#pragma unroll
    for (int j = 0; j < 8; ++j) zr[j] = *(const v4u*)(F.PROJ + (size_t)(rb.m0 + F.wave + 8 * j - F.sc_row0) * PP + C_CZ + 8 * lane);
#pragma unroll
    for (int j = 0; j < 8; ++j) *(LAS v4u*)(Zs + (F.wave + 8 * j) * 520 + 8 * lane) = zr[j];
    __syncthreads();
#pragma unroll
    for (int db = 0; db < 4; ++db) { const int c = g * 128 + (db0 + db) * 16 + 4 * fq;
#pragma unroll
        for (int tb = 0; tb < 4; ++tb) { const int t = tb * 16 + fr; const size_t row = (size_t)(rb.m0 + t - F.sc_row0); const v2u z = *(const LAS v2u*)(Zs + t * 520 + c); const f32x4 a = acc[db][tb];
            v2u o; o.x = pk2(a[0] * bflo(z.x), a[1] * bfhi(z.x)); o.y = pk2(a[2] * bflo(z.y), a[3] * bfhi(z.y));
            (void)row; *(LAS v2u*)(Pp + t * 520 + c) = o; } }
    __syncthreads();
#pragma unroll
    for (int j = 0; j < 8; ++j) { const int t = F.wave + 8 * j;
        *(v4u*)(Oc + (size_t)(rb.m0 + t - F.sc_row0) * 512 + 8 * lane) = *(const LAS v4u*)(Pp + t * 520 + 8 * lane); }
    __syncthreads();
}

__device__ __forceinline__ void mix_D(Frame& F, ArgP A, const RowBlk rb) {
    const int l = F.l, lane = F.lane, c = 8 * lane; const int nb = rb.smp ? 8 : 16;
    float w0[8], w1[8], w2[8];
#pragma unroll
    for (int i = 0; i < 8; ++i) { w0[i] = A->in[I_CONVDW][(l * 3 + 0) * 512 + c + i]; w1[i] = A->in[I_CONVDW][(l * 3 + 1) * 512 + c + i]; w2[i] = A->in[I_CONVDW][(l * 3 + 2) * 512 + c + i]; }
    const int tl0 = F.wave * 8;
    float u2[8], u1[8];
    if (tl0 == 0 && rb.first) {
        if (rb.smp) { const float* sp = A->in[I_SSHORT] + ((size_t)(l * 8 + rb.b) * 2) * 512 + c;
#pragma unroll
            for (int i = 0; i < 8; ++i) { u2[i] = sp[i]; u1[i] = sp[512 + i]; } }
        else {
#pragma unroll
            for (int i = 0; i < 8; ++i) { u2[i] = 0.f; u1[i] = 0.f; } }
    } else {
        const bf16* p2 = F.PROJ + (size_t)(rb.m0 + tl0 - 2 - F.sc_row0) * PP; const bf16* p1 = p2 + PP;
        unpack8(*(const v4u*)(p2 + C_DC + c), u2); unpack8(*(const v4u*)(p1 + C_DC + c), u1);
    }
    bf16* Od = F.OUTS + (size_t)3 * F.rtm * 256 * 512;
    v4u q[8][2];
#pragma unroll
    for (int i = 0; i < 8; ++i) { const bf16* pr = F.PROJ + (size_t)(rb.m0 + tl0 + i - F.sc_row0) * PP; q[i][0] = *(const v4u*)(pr + C_DB + c); q[i][1] = *(const v4u*)(pr + C_DC + c); }
#pragma unroll
    for (int i = 0; i < 8; ++i) { asm volatile("" : "+v"(q[i][0])); asm volatile("" : "+v"(q[i][1])); }
#pragma unroll
    for (int i = 0; i < 8; ++i) { const int tl = tl0 + i; const size_t row = (size_t)(rb.m0 + tl - F.sc_row0);
        float dbz[8], u[8], o[8];
        unpack8(q[i][0], dbz); unpack8(q[i][1], u);
#pragma unroll
        for (int k = 0; k < 8; ++k) o[k] = dbz[k] * (u2[k] * w0[k] + u1[k] * w1[k] + u[k] * w2[k]);
        *(v4u*)(Od + row * 512 + c) = pack8(o);
        if (rb.last && tl >= 62) { float* so = F.out + (rb.smp ? O_SHORTS : O_SHORTP) + ((size_t)(l * nb + rb.b) * 2 + (tl - 62)) * 512 + c;
            *(f32x4*)so = (f32x4){u[0], u[1], u[2], u[3]}; *(f32x4*)(so + 4) = (f32x4){u[4], u[5], u[6], u[7]}; }
#pragma unroll
        for (int k = 0; k < 8; ++k) { u2[k] = u1[k]; u1[k] = u[k]; }
    }
}
#ifndef PROBE_MIX_A
#define PROBE_MIX_A 1
#endif
#ifndef PROBE_MIX_B
#define PROBE_MIX_B 1
#endif
#ifndef PROBE_MIX_C
#define PROBE_MIX_C 1
#endif
#ifndef PROBE_MIX_D
#define PROBE_MIX_D 1
#endif
__device__ __forceinline__ void phase_mix(Frame& F, ArgP A) {
    const int nrb = F.R >> 6;
#ifndef DIS_B
#pragma unroll 1
    for (int rp = 0; rp < PROBE_MIX_B; ++rp)
#pragma unroll 1
    for (int t = (F.vcu + F.G - (0 * nrb) % F.G) % F.G; t < nrb; t += F.G) mix_B(F, A, row_blk(F.sc_row0 + t * 64));
#endif
#ifndef DIS_A
    { const int Rp = (MP - F.sc_row0) < F.R ? (MP - F.sc_row0) : F.R; const int npc = Rp >> 7, nch = npc + ((F.R - Rp) >> 6);
#pragma unroll 1
    for (int rp = 0; rp < PROBE_MIX_A; ++rp)
#pragma unroll 1
    for (int t = (F.vcu + F.G - (1 * nrb) % F.G) % F.G; t < nch; t += F.G) { const bool pc = t < npc; mix_A(F, A, F.sc_row0 + (pc ? 128 * t : Rp + 64 * (t - npc)), pc ? 128 : 64); } }
#endif
#ifndef DIS_C
#pragma unroll 1
    for (int rp = 0; rp < PROBE_MIX_C; ++rp)
#pragma unroll 1
    for (int t = (F.vcu + F.G - (2 * nrb) % F.G) % F.G; t < nrb; t += F.G) mix_C(F, A, row_blk(F.sc_row0 + t * 64));
#endif
#ifndef DIS_D
#pragma unroll 1
    for (int rp = 0; rp < PROBE_MIX_D; ++rp)
#pragma unroll 1
    for (int t = (F.vcu + F.G - (3 * nrb) % F.G) % F.G; t < nrb; t += F.G) mix_D(F, A, row_blk(F.sc_row0 + t * 64));
#endif
}
template <int K> __device__ __forceinline__ f32x4 small_tile(const bf16* Arow, const bf16* Brow) {
    f32x4 acc = (f32x4){0.f, 0.f, 0.f, 0.f};
#pragma unroll 16
    for (int ks = 0; ks < K / 32; ++ks) { const bf16x8 a = *(const bf16x8*)(Arow + ks * 32), b = *(const bf16x8*)(Brow + ks * 32); acc = __builtin_amdgcn_mfma_f32_16x16x32_bf16(b, a, acc, 0, 0, 0); }
    return acc;
}
__device__ __forceinline__ void sample_branch(Frame& F, int Mp) {
    const int fr = F.lane & 15, fq = F.lane >> 4; const bf16* wb_t = (const bf16*)(F.ws + WS_WB);
#pragma unroll 1
    for (int tile = F.vcu; tile < 256; tile += F.G) {
        const int r0 = Mp + (tile >> 4) * 32 + (F.wave >> 2) * 16, c0 = (tile & 15) * 64 + (F.wave & 3) * 16; const size_t row = (size_t)(r0 + fr);
        f32x4 tot = (f32x4){0.f, 0.f, 0.f, 0.f};
#pragma unroll 1
        for (int X = 0; X < 4; ++X) {
            const f32x4 a = small_tile<512>(F.OUTS + (size_t)X * F.rtm * 256 * 512 + row * 512 + 8 * fq, wb_t + ((size_t)(F.l * 4 + X) * 1024 + c0 + fr) * 512 + 8 * fq);
            const int r_t = (int)(row & 255), c_t = (c0 + 4 * fq) & 255, cq = (c0 + 4 * fq) >> 8;
            const unsigned char* gp = F.G8 + (row >> 8) * 1048576 + (size_t)(4 * X + cq) * 65536
                + (((r_t >> 7) * 4 + ((r_t >> 4) & 3)) * 2 + (c_t >> 7)) * 4096 + ((((r_t >> 6) & 1) * 4 + ((c_t >> 5) & 3)) * 512) + ((r_t & 15) + 16 * ((c_t >> 3) & 3)) * 8 + (c_t & 7);
            const unsigned g = *(const unsigned*)gp;
            float r0 = (float)(g & 255u), r1 = (float)((g >> 8) & 255u), r2 = (float)((g >> 16) & 255u), r3 = (float)(g >> 24);
            if (X < 3) { const unsigned h = *(const unsigned*)(gp + 4 * 65536); r0 *= __builtin_amdgcn_rcpf((float)(h & 255u)); r1 *= __builtin_amdgcn_rcpf((float)((h >> 8) & 255u)); r2 *= __builtin_amdgcn_rcpf((float)((h >> 16) & 255u)); r3 *= __builtin_amdgcn_rcpf((float)(h >> 24)); }
            else { r0 *= (1.0f / 255.0f); r1 *= (1.0f / 255.0f); r2 *= (1.0f / 255.0f); r3 *= (1.0f / 255.0f); }
            tot[0] = (tot[0] + a[0]) * r0; tot[1] = (tot[1] + a[1]) * r1; tot[2] = (tot[2] + a[2]) * r2; tot[3] = (tot[3] + a[3]) * r3;
        }
        v2u o; o.x = pk2(tot[0], tot[1]); o.y = pk2(tot[2], tot[3]);
        *(v2u*)(F.H + row * 1024 + c0 + 4 * fq) = o;
    }
}
__device__ __forceinline__ void sample_out(Frame& F, int Mp) {
    const int fr = F.lane & 15, fq = F.lane >> 4; const bf16* wo_t = (const bf16*)(F.ws + WS_WO);
#pragma unroll 1
    for (int tile = F.vcu; tile < 256; tile += F.G) {
        const int r0 = Mp + (tile >> 4) * 32 + (F.wave >> 2) * 16, c0 = (tile & 15) * 64 + (F.wave & 3) * 16; const size_t row = (size_t)(r0 + fr);
        const f32x4 a = small_tile<1024>(F.H + row * 1024 + 8 * fq, wo_t + ((size_t)F.l * 1024 + c0 + fr) * 1024 + 8 * fq);
        v2u o; o.x = pk2(a[0], a[1]); o.y = pk2(a[2], a[3]);
        *(v2u*)(F.OUTS + row * 1024 + c0 + 4 * fq) = o;
    }
}
__device__ __forceinline__ void phase_E(Frame& F, ArgP A) {
    const int l = F.l, lane = F.lane; const int gw = F.vcu * NWAVES + F.wave, NGW = F.G * NWAVES;
    const bf16* Y = F.OUTS; float* xo = F.out + O_Y;
    const float* gpost = A->in[I_GPOST] + l * DM; const float* gnext = A->in[I_GPRE] + (l + 1 < DEPTH ? (l + 1) * DM : 0);
#pragma unroll 1
    for (int rr0 = gw; rr0 < F.R; rr0 += 2 * NGW) {
        v4u yraw[2][2]; f32x4 xv[2][4];
#pragma unroll
        for (int u = 0; u < 2; ++u) { const int rq = rr0 + u * NGW; const int r = rq < F.R ? rq : rr0; const int m = F.sc_row0 + r;
#pragma unroll
            for (int i = 0; i < 2; ++i) yraw[u][i] = *(const v4u*)(Y + (size_t)r * DM + 8 * lane + 512 * i);
            if (l == 0) { const float* xr = xin_row(F, A, m);
#pragma unroll
                for (int i = 0; i < 2; ++i) { xv[u][2 * i] = *(const f32x4*)(xr + 8 * lane + 512 * i); xv[u][2 * i + 1] = *(const f32x4*)(xr + 8 * lane + 512 * i + 4); } }
            else { const bf16* x16 = F.X1 + (size_t)r * DM;
#pragma unroll
                for (int i = 0; i < 2; ++i) { float t8[8]; unpack8(*(const v4u*)(x16 + 8 * lane + 512 * i), t8);
                    xv[u][2 * i] = (f32x4){t8[0], t8[1], t8[2], t8[3]}; xv[u][2 * i + 1] = (f32x4){t8[4], t8[5], t8[6], t8[7]}; } } }
#pragma unroll
        for (int u = 0; u < 2; ++u) { const int r = rr0 + u * NGW; if (r < F.R) { const int m = F.sc_row0 + r;
            float y[16]; float s = 0.f;
#pragma unroll
            for (int i = 0; i < 2; ++i) { float t8[8]; unpack8(yraw[u][i], t8);
#pragma unroll
                for (int k = 0; k < 8; ++k) { y[8 * i + k] = t8[k]; s += t8[k] * t8[k]; } }
            const float rr = rsqrtf(wave_sum(s) * (1.f / DM) + EPS); float s2 = 0.f;
#pragma unroll
            for (int i = 0; i < 4; ++i) { const f32x4 g = *(const f32x4*)(gpost + 8 * lane + 512 * (i >> 1) + 4 * (i & 1)); f32x4 xx = xv[u][i];
                xx.x += y[4 * i + 0] * rr * g.x; xx.y += y[4 * i + 1] * rr * g.y; xx.z += y[4 * i + 2] * rr * g.z; xx.w += y[4 * i + 3] * rr * g.w;
                s2 += (xx.x * xx.x + xx.y * xx.y) + (xx.z * xx.z + xx.w * xx.w); xv[u][i] = xx;
                if (l + 1 == DEPTH) *(f32x4*)(xo + (size_t)m * DM + 8 * lane + 512 * (i >> 1) + 4 * (i & 1)) = xx; }
            if (l + 1 < DEPTH) { const float r2 = rsqrtf(wave_sum(s2) * (1.f / DM) + EPS); bf16* x16 = F.X1 + (size_t)r * DM;
#pragma unroll
                for (int i = 0; i < 2; ++i) { const f32x4 g0 = *(const f32x4*)(gnext + 8 * lane + 512 * i), g1 = *(const f32x4*)(gnext + 8 * lane + 512 * i + 4);
                    const f32x4 xa = xv[u][2 * i], xb = xv[u][2 * i + 1];
                    v4u xs; xs.x = pk2(xa.x, xa.y); xs.y = pk2(xa.z, xa.w); xs.z = pk2(xb.x, xb.y); xs.w = pk2(xb.z, xb.w);
                    *(v4u*)(x16 + 8 * lane + 512 * i) = xs;
                    const f32x4 a = xa * r2 * g0, b = xb * r2 * g1; v4u o; o.x = pk2(a.x, a.y); o.y = pk2(a.z, a.w); o.z = pk2(b.x, b.y); o.w = pk2(b.z, b.w);
                    *(v4u*)(F.H + (size_t)r * DM + 8 * lane + 512 * i) = o; } }
        } }
    }
}

#define XB_TMO      128
#define XB_XCNT(j)  (256  + 64 * (j))
#define XB_XSUB(j)  (1280 + 64 * (j))
#define XB_XGEN(j)  (2304 + 64 * (j))
#define XB_TOP      3328
#define XB_TOPGEN   3392
#define XCD_BAR_WORDS 3456
#define XB_SPIN_CAP (1u << 18)

__device__ __forceinline__ unsigned xb_ld(unsigned* p)              { return __hip_atomic_load(p, __ATOMIC_RELAXED, __HIP_MEMORY_SCOPE_AGENT); }
__device__ __forceinline__ unsigned xb_add(unsigned* p, unsigned v) { return __hip_atomic_fetch_add(p, v, __ATOMIC_RELAXED, __HIP_MEMORY_SCOPE_AGENT); }
__device__ __forceinline__ unsigned xb_xcc_id() { return (unsigned)__builtin_amdgcn_s_getreg((3 << 11) | 20) & 0xFu; }
#define XB_SPIN(cond, bar) do { unsigned _sp = 0; while (cond) { __builtin_amdgcn_s_sleep(1); \
    if ((++_sp & 255u) == 0u) { if (xb_ld(&(bar)[XB_TMO])) break; if (_sp > XB_SPIN_CAP) { atomicAdd(&(bar)[XB_TMO], 1u); break; } } } } while (0)

struct XcdBarrier {
    unsigned* bar; unsigned x;
    volatile LAS unsigned* st;
};

__device__ __forceinline__ XcdBarrier xcd_barrier_post(unsigned* bar, volatile LAS unsigned* st) {
    XcdBarrier b; b.bar = bar; b.x = xb_xcc_id(); b.st = st;
    if (threadIdx.x == 0) (void)xb_add(&bar[XB_XCNT(b.x)], 1u);
    return b;
}
__device__ __forceinline__ void xcd_barrier_complete(unsigned* bar, unsigned x, unsigned& nloc, unsigned& nx) {
    const unsigned G = gridDim.x * gridDim.y * gridDim.z;
    unsigned sum, cnt, mine, sp = 0u;
    for (;;) {
        sum = 0u; cnt = 0u; mine = 0u;
#pragma unroll
        for (unsigned j = 0; j < 16; ++j) { const unsigned c = xb_ld(&bar[XB_XCNT(j)]); sum += c; cnt += (c > 0u) ? 1u : 0u; mine = (j == x) ? c : mine; }
        if (sum == G) break;
        __builtin_amdgcn_s_sleep(1);
        if ((++sp & 255u) == 0u) { if (xb_ld(&bar[XB_TMO])) break; if (sp > XB_SPIN_CAP) { atomicAdd(&bar[XB_TMO], 1u); break; } }
    }
    nloc = mine > 0u ? mine : 1u; nx = cnt > 0u ? cnt : 1u;
}

__device__ __forceinline__ void xcd_barrier(const XcdBarrier& b) {
    asm volatile("s_waitcnt vmcnt(0)" ::: "memory");
    __syncthreads();
    if (threadIdx.x == 0) {
        unsigned* bar = b.bar;
        __builtin_amdgcn_s_waitcnt(0);
        unsigned nloc = b.st[0], nx = b.st[1];
        if (nloc == 0u) { xcd_barrier_complete(bar, b.x, nloc, nx); b.st[0] = nloc; b.st[1] = nx; }
        const unsigned old = xb_add(&bar[XB_XSUB(b.x)], 1u);
        const unsigned gen = old / nloc;
        if (old + 1u == (gen + 1u) * nloc) {
            __builtin_amdgcn_fence(__ATOMIC_RELEASE, "agent");
            asm volatile("s_waitcnt vmcnt(0)" ::: "memory");
            const unsigned og = xb_add(&bar[XB_TOP], 1u);
            const unsigned tg = og / nx;
            if (og + 1u == (tg + 1u) * nx) xb_add(&bar[XB_TOPGEN], 1u);
            else XB_SPIN(xb_ld(&bar[XB_TOPGEN]) == tg, bar);
            __builtin_amdgcn_fence(__ATOMIC_ACQUIRE, "agent");
            xb_add(&bar[XB_XGEN(b.x)], 1u);
            asm volatile("s_waitcnt vmcnt(0)" ::: "memory");
        } else {
            XB_SPIN(xb_ld(&bar[XB_XGEN(b.x)]) == gen, bar);
            __builtin_amdgcn_fence(__ATOMIC_ACQUIRE, "agent");
            asm volatile("s_waitcnt vmcnt(0)" ::: "memory");
        }
    }
    __syncthreads();
}

constexpr int CW_BAR = 4096;
constexpr int LDS_BARST = LDS_BYTES - 64;
#ifndef PROBE_REP
#define PROBE_REP 0
#endif
#ifndef PROBE_BAR2
#define PROBE_BAR2 0
#endif
__global__ void __launch_bounds__(NWAVES * 64, 2) mega_fwd(Args args) {
    extern __shared__ __attribute__((aligned(16))) unsigned char lds[];
    cg::grid_group grid = cg::this_grid();
    Frame F;
    F.lds = (LAS unsigned char*)lds;
    if (threadIdx.x < 16) ((LAS unsigned*)(F.lds + LDS_BARST))[threadIdx.x] = 0u;
    __syncthreads();
    if (args.ph_hi - args.ph_lo > 1) (void)xcd_barrier_post((unsigned*)(args.ws + WS_CTL) + CW_BAR, (volatile LAS unsigned*)(F.lds + LDS_BARST));
    const int lo = args.ph_lo, hi = args.ph_hi;
    ArgP ap = (ArgP)__builtin_amdgcn_kernarg_segment_ptr();
#if PROBE_REP
    int rep_done = 0;
#endif
#pragma unroll 1
    for (int ph = lo; ph < hi; ++ph) {
        asm volatile("" : "+s"(ap));
        int tid_ = threadIdx.x, bx = blockIdx.x; asm volatile("" : "+v"(tid_)); asm volatile("" : "+s"(bx));
        F.tid = tid_; F.lane = F.tid & 63; F.wave = __builtin_amdgcn_readfirstlane(F.tid >> 6);
        F.G = gridDim.x; F.vcu = (F.G % 8 == 0) ? (bx % 8) * (F.G / 8) + bx / 8 : bx;
        const int nsc = ap->nsc, tps = NTP / nsc;
        F.out = ap->out; F.ws = ap->ws; F.rtm = tps + 2;
        F.H = (bf16*)(F.ws + WS_H); F.OUTS = F.H + (size_t)F.rtm * 256 * 1024; F.PROJ = F.OUTS + (size_t)F.rtm * 256 * 2048; F.X1 = F.PROJ + (size_t)F.rtm * 256 * PP;
        if (ph == 0) {
#ifndef DIS_P
            phase_prep(F, ap, tps * 256 + (nsc == 1 ? MS : 0));
#endif
        } else {
            const int q = ph - 1, s = q / 10, l = (q / 5) & 1, k = q % 5;
            F.sc_row0 = s * tps * 256; F.R = (tps + (s == nsc - 1 ? 2 : 0)) * 256; F.l = l;
            F.G8 = (unsigned char*)(F.out + O_Y) + (size_t)F.sc_row0 * 4096;
            if (k == 0) {
                pg8::Gemm g{F.H, (const bf16*)(F.ws + WS_WIN) + (size_t)l * NIN * DM, F.R, NIN, DM}; pg8::StaticOrder S; S.init(F.R, NIN, F.G, bx);
                pg8::EpiProj E{F.PROJ, ap->in[I_BGATE] + l * 4096, F.G8};
#ifndef DIS_G1
#if defined(PROBE_SAME) && PROBE_REP
                if (!rep_done) { pg8::SameOrder S2; S2.init(F.R, NIN, F.G, bx); pg8::gemm_phase<pg8::EpiProj, pg8::SameOrder, PG8_ALIGN, PG8_SP2>(F.lds, g, S2, E); } else
#endif
                pg8::gemm_phase<pg8::EpiProj, pg8::StaticOrder, PG8_ALIGN, PG8_SP2>(F.lds, g, S, E);
#endif
            } else if (k == 1) {
                phase_mix(F, ap);
            } else if (k == 2) {
                const int Mp = tps * 256;
                pg8::Gemm g{F.OUTS, (const bf16*)(F.ws + WS_WB) + (size_t)l * 4 * DM * WBR, Mp, DM, WBR}; pg8::BranchOrder S; S.init(Mp, F.G, bx, F.rtm); S.proj = F.PROJ; S.junk = F.lds + 131072; S.tid = F.tid;
                pg8::EpiBranch E{F.H, F.PROJ, F.rtm, F.G8};
#ifndef DIS_G2
                pg8::gemm_phase<pg8::EpiBranch, pg8::BranchOrder, PG8_ALIGN, PG8_SP2>(F.lds, g, S, E);
#endif
                if (F.R > Mp) sample_branch(F, Mp);
            } else if (k == 3) {
                const int Mp = tps * 256;
                pg8::Gemm g{F.H, (const bf16*)(F.ws + WS_WO) + (size_t)l * DM * DM, Mp, DM, DM}; pg8::StaticOrder S; S.init(Mp, DM, F.G, bx);
                pg8::EpiPlain E{F.OUTS, DM};
#ifndef DIS_G3
                pg8::gemm_phase<pg8::EpiPlain, pg8::StaticOrder, PG8_ALIGN, PG8_SP2>(F.lds, g, S, E);
#endif
                if (F.R > Mp) sample_out(F, Mp);
            } else {
#ifndef DIS_E
                phase_E(F, ap);
                if (l == DEPTH - 1 && s + 1 < nsc) { const int r0 = (s + 1) * tps * 256, nr = (tps + (s + 1 == nsc - 1 ? 2 : 0)) * 256; prenorm_rows(F, ap, r0, nr, F.H); }
#endif
            }
        }
        if (ph + 1 < hi) {
            if (ph == 0) grid.sync();
            else { XcdBarrier xb; xb.bar = (unsigned*)(ap->ws + WS_CTL) + CW_BAR; xb.x = xb_xcc_id(); xb.st = (volatile LAS unsigned*)(F.lds + LDS_BARST); xcd_barrier(xb);
#if PROBE_BAR2
                xcd_barrier(xb);
#endif
            }
        }
#if PROBE_REP
        { const int kk_ = (ph == 0) ? 5 : (ph - 1) % 5; const bool want = ((PROBE_REP >> kk_) & 1) && !(kk_ == 4 && (((ph - 1) / 5) & 1)) && ph > 0 && ph + 1 < hi;
          if (want && !rep_done) { rep_done = 1; --ph; } else rep_done = 0; }
#endif
    }
}


extern "C" void kernel_launch(void* const* d_in, const int* in_sizes, int n_in, void* d_out, int out_size, void* d_ws, size_t ws_size, hipStream_t stream) {
    static int grid = 0, nsc = 0;
    if (grid == 0) {
        if (n_in != 22 || in_sizes[0] != MP * DM || (size_t)out_size != O_END) { fprintf(stderr, "kernel_launch: unexpected shapes (n_in %d, in0 %d, out %d)\n", n_in, n_in > 0 ? in_sizes[0] : -1, out_size); grid = -1; return; }
        nsc = 0;
        for (int c = 1; c <= 16; c *= 2) if (ws_size >= ws_need(NTP / c + 2)) { nsc = c; break; }
        if (nsc == 1) nsc = 2;
        if (nsc == 0) { fprintf(stderr, "kernel_launch: workspace too small (%zu)\n", ws_size); grid = -1; return; }
        int dev = 0, cus = 0, per_cu = 0;
        if (hipGetDevice(&dev) != hipSuccess || hipDeviceGetAttribute(&cus, hipDeviceAttributeMultiprocessorCount, dev) != hipSuccess) { grid = -1; return; }
        if (hipFuncSetAttribute((const void*)mega_fwd, hipFuncAttributeMaxDynamicSharedMemorySize, LDS_BYTES) != hipSuccess) { fprintf(stderr, "kernel_launch: hipFuncSetAttribute failed\n"); grid = -1; return; }
        if (hipOccupancyMaxActiveBlocksPerMultiprocessor(&per_cu, (const void*)mega_fwd, NWAVES * 64, LDS_BYTES) != hipSuccess || per_cu < 1) { fprintf(stderr, "kernel_launch: occupancy query says %d\n", per_cu); }
        (void)hipGetLastError();
        grid = cus;
        fprintf(stderr, "kernel_launch: grid %d, nsc %d, ws %zu\n", grid, nsc, ws_size);
    }
    if (grid < 0) return;
    if (hipMemsetAsync((char*)d_ws + WS_CTL, 0, CTL_ZERO_BYTES, stream) != hipSuccess) { fprintf(stderr, "kernel_launch: memset failed\n"); return; }
    Args a{};
    for (int i = 0; i < 22; ++i) a.in[i] = (const float*)d_in[i];
    a.out = (float*)d_out; a.ws = (unsigned char*)d_ws; a.nsc = nsc; a.pad = 0;
    const int nph = 1 + nsc * DEPTH * 5;
#if MK_PER_PHASE
    for (int p = 0; p < nph; ++p) { a.ph_lo = p; a.ph_hi = p + 1; hipLaunchKernelGGL(mega_fwd, dim3(grid), dim3(NWAVES * 64), LDS_BYTES, stream, a); }
#else
    a.ph_lo = 0; a.ph_hi = nph;
    void* kargs[] = {&a};
    hipError_t e = hipLaunchCooperativeKernel((const void*)mega_fwd, dim3(grid), dim3(NWAVES * 64), kargs, LDS_BYTES, stream);
    if (e != hipSuccess) fprintf(stderr, "kernel_launch: cooperative launch failed: %s\n", hipGetErrorString(e));
#endif
}
```
